# Optimizing an MI355X kernel written in HIP

```python
import jax
import jax.numpy as jnp
from jax import lax
import numpy as np

D_MODEL = 1024
BATCH = 4
SEQ = 8192
DEPTH = 2

ATT_HEADS = 8
ATT_HEAD_DIM = 64
ATT_WIDTH = ATT_HEADS * ATT_HEAD_DIM
IDX_HEADS = 4
IDX_DIM = 64
TOPK_MAX = 256
Q_BLOCK = 128
M_HEADS = 4
M_HEAD_DIM = 128
M_WIDTH = M_HEADS * M_HEAD_DIM
CHUNK = 128
CONV_K = 4
D_FF = 2816
ROPE_THETA = 10000.0
EPS = 1e-6
IN_SIZES = (ATT_WIDTH, ATT_HEAD_DIM, ATT_HEAD_DIM, IDX_HEADS * IDX_DIM, IDX_DIM, IDX_HEADS, 2 * M_WIDTH, M_WIDTH, M_WIDTH, M_HEADS, M_HEADS)
IN_COLS = ATT_WIDTH + 2 * ATT_HEAD_DIM + IDX_HEADS * IDX_DIM + IDX_DIM + IDX_HEADS + 4 * M_WIDTH + 2 * M_HEADS

kernel_name = "hybrid_dsa_mlstm_macaron"


def rmsnorm(x, g):
    xf = x.astype(jnp.float32)
    y = xf * lax.rsqrt(jnp.mean(xf * xf, axis=-1, keepdims=True) + EPS) * g.astype(jnp.float32)
    return y.astype(x.dtype)


def swiglu(x, w_gate, w_up, w_down):
    return (jax.nn.silu(x @ w_gate) * (x @ w_up)) @ w_down


def rope(x, pos):
    half = x.shape[-1] // 2
    inv_freq = ROPE_THETA ** (-jnp.arange(half, dtype=jnp.float32) / half)
    ang = pos.astype(jnp.float32)[:, None] * inv_freq[None, :]
    cos = jnp.cos(ang)[:, None, :]
    sin = jnp.sin(ang)[:, None, :]
    xf = x.astype(jnp.float32)
    x1, x2 = xf[..., :half], xf[..., half:]
    return jnp.concatenate([x1 * cos - x2 * sin, x2 * cos + x1 * sin], axis=-1).astype(x.dtype)


def causal_conv(x, w, b):
    y = lax.conv_general_dilated(x, w.astype(x.dtype), window_strides=(1,), padding=[(CONV_K - 1, 0)],
                                 dimension_numbers=("NWC", "WIO", "NWC"), feature_group_count=x.shape[-1])
    return y + b


def split_columns(proj):
    offsets = np.cumsum(IN_SIZES)[:-1].tolist()
    return jnp.split(proj, offsets, axis=-1)


def dsa_attention(q, k, v, q_idx, k_idx, w_idx):
    B, S = q.shape[0], q.shape[1]
    topk = min(TOPK_MAX, S // 4)
    nb = S // Q_BLOCK
    key_pos = jnp.arange(S, dtype=jnp.int32)

    def to_blocks(a):
        return jnp.moveaxis(a.reshape((B, nb, Q_BLOCK) + a.shape[2:]), 1, 0)

    def gather(src, idx):
        return jax.vmap(lambda sb, ib: sb[ib])(src, idx)

    def one_block(args):
        qb, qib, wb, start = args
        q_pos = start + jnp.arange(Q_BLOCK, dtype=jnp.int32)
        idx_logits = jnp.einsum("bqhd,bsd->bqhs", qib, k_idx, preferred_element_type=jnp.float32) * IDX_DIM ** -0.5
        index_score = jnp.einsum("bqhs,bqh->bqs", jax.nn.relu(idx_logits), wb.astype(jnp.float32))
        index_score = jnp.where(key_pos[None, None, :] <= q_pos[None, :, None], index_score, -jnp.inf)
        _, sel = lax.top_k(index_score, topk)
        k_sel = gather(k, sel)
        v_sel = gather(v, sel)
        logits = jnp.einsum("bqhd,bqkd->bqhk", qb, k_sel, preferred_element_type=jnp.float32) * ATT_HEAD_DIM ** -0.5
        valid = (sel <= q_pos[None, :, None])[:, :, None, :]
        p = jax.nn.softmax(jnp.where(valid, logits, -jnp.inf), axis=-1)
        return jnp.einsum("bqhk,bqkd->bqhd", p.astype(v_sel.dtype), v_sel)

    starts = jnp.arange(nb, dtype=jnp.int32) * Q_BLOCK
    out = lax.map(one_block, (to_blocks(q), to_blocks(q_idx), to_blocks(w_idx), starts))
    return jnp.moveaxis(out, 0, 1).reshape(B, S, ATT_WIDTH)


def mlstm(q, k, v, i_pre, f_pre):
    B, S, NH, d = q.shape
    nc = S // CHUNK

    def chunks(a):
        a = a.astype(jnp.float32).reshape((B, nc, CHUNK, NH) + a.shape[3:])
        return jnp.moveaxis(a, 3, 1)

    qc = chunks(q)
    kc = chunks(k) * d ** -0.5
    vc = chunks(v)
    ic = chunks(i_pre)
    b = jnp.cumsum(jax.nn.log_sigmoid(chunks(f_pre)), axis=-1)
    b_last = b[..., -1]

    a = b_last[..., None] - b + ic
    a_max = a.max(axis=-1)
    wa = jnp.exp(a - a_max[..., None])
    c_chunk = jnp.einsum("bhcl,bhcld,bhcle->bhcde", wa, kc, vc)
    n_chunk = jnp.einsum("bhcl,bhcld->bhcd", wa, kc)

    def step(carry, xs):
        C, n, m = carry
        bl, am, Cc, ncu = xs
        m_new = jnp.maximum(bl + m, am)
        s_old = jnp.exp(bl + m - m_new)
        s_new = jnp.exp(am - m_new)
        C_new = s_old[..., None, None] * C + s_new[..., None, None] * Cc
        n_new = s_old[..., None] * n + s_new[..., None] * ncu
        return (C_new, n_new, m_new), (C, n, m)

    init = (jnp.zeros((B, NH, d, d), jnp.float32), jnp.zeros((B, NH, d), jnp.float32), jnp.zeros((B, NH), jnp.float32))
    xs = (jnp.moveaxis(b_last, 2, 0), jnp.moveaxis(a_max, 2, 0), jnp.moveaxis(c_chunk, 2, 0), jnp.moveaxis(n_chunk, 2, 0))
    _, (C_prev, n_prev, m_prev) = lax.scan(step, init, xs)
    C_prev = jnp.moveaxis(C_prev, 0, 2)
    n_prev = jnp.moveaxis(n_prev, 0, 2)
    m_prev = jnp.moveaxis(m_prev, 0, 2)

    g = b + m_prev[..., None]
    causal = jnp.tril(jnp.ones((CHUNK, CHUNK), dtype=bool))
    dmat = jnp.where(causal, b[..., :, None] - b[..., None, :] + ic[..., None, :], -jnp.inf)
    m_t = jnp.maximum(g, dmat.max(axis=-1))
    w_intra = jnp.exp(dmat - m_t[..., None])
    w_inter = jnp.exp(g - m_t)
    s = jnp.einsum("bhcld,bhcsd->bhcls", qc, kc) * w_intra
    num = w_inter[..., None] * jnp.einsum("bhcld,bhcde->bhcle", qc, C_prev) + jnp.einsum("bhcls,bhcse->bhcle", s, vc)
    den = w_inter * jnp.einsum("bhcld,bhcd->bhcl", qc, n_prev) + s.sum(axis=-1)
    h = num / jnp.maximum(jnp.abs(den), jnp.exp(-m_t))[..., None]
    return jnp.moveaxis(h, 1, 3).reshape(B, S, NH, d)


def hybrid_mixer(h, pos, w_in, conv_w, conv_b, gate_b, q_norm, k_norm, m_norm, w_out):
    B, S, _ = h.shape
    q, k, v, q_idx, k_idx, w_idx, qk_m, v_m, o_m, i_pre, f_pre = split_columns(h @ w_in)
    q = rope(rmsnorm(q.reshape(B, S, ATT_HEADS, ATT_HEAD_DIM), q_norm), pos)
    k = rope(rmsnorm(k, k_norm)[:, :, None, :], pos)[:, :, 0, :]
    q_idx = rope(q_idx.reshape(B, S, IDX_HEADS, IDX_DIM), pos)
    k_idx = rope(k_idx[:, :, None, :], pos)[:, :, 0, :]
    att = dsa_attention(q, k, v, q_idx, k_idx, w_idx * IDX_HEADS ** -0.5)
    qk_m = jax.nn.silu(causal_conv(qk_m, conv_w, conv_b))
    q_m, k_m = jnp.split(qk_m, 2, axis=-1)
    shape_m = (B, S, M_HEADS, M_HEAD_DIM)
    h_m = mlstm(q_m.reshape(shape_m), k_m.reshape(shape_m), v_m.reshape(shape_m),
                i_pre + gate_b[:M_HEADS], f_pre + gate_b[M_HEADS:])
    h_m = rmsnorm(h_m, m_norm).reshape(B, S, M_WIDTH).astype(h.dtype) * jax.nn.sigmoid(o_m)
    return jnp.concatenate([att, h_m], axis=-1) @ w_out


def setup_inputs(seed: int = 0) -> dict:
    key = jax.random.key(seed)
    keys = jax.random.split(key, 19)

    def nrm(k, shape, scale):
        return scale * jax.random.normal(k, shape, jnp.float32)

    mix_w = ATT_WIDTH + M_WIDTH
    return {
        "x": nrm(keys[0], (BATCH, SEQ, D_MODEL), 1.0),
        "ffn1_norm": 1.0 + nrm(keys[1], (DEPTH, D_MODEL), 0.02),
        "ffn1_w_gate": nrm(keys[2], (DEPTH, D_MODEL, D_FF), D_MODEL ** -0.5),
        "ffn1_w_up": nrm(keys[3], (DEPTH, D_MODEL, D_FF), D_MODEL ** -0.5),
        "ffn1_w_down": nrm(keys[4], (DEPTH, D_FF, D_MODEL), D_FF ** -0.5),
        "mix_norm": 1.0 + nrm(keys[5], (DEPTH, D_MODEL), 0.02),
        "w_in": nrm(keys[6], (DEPTH, D_MODEL, IN_COLS), D_MODEL ** -0.5),
        "conv_w": nrm(keys[7], (DEPTH, CONV_K, 1, 2 * M_WIDTH), CONV_K ** -0.5),
        "conv_b": nrm(keys[8], (DEPTH, 2 * M_WIDTH), 0.02),
        "gate_b": jnp.concatenate([nrm(keys[9], (DEPTH, M_HEADS), 0.1),
                                   3.0 + nrm(keys[10], (DEPTH, M_HEADS), 0.5)], axis=-1),
        "q_norm": 1.0 + nrm(keys[11], (DEPTH, ATT_HEAD_DIM), 0.02),
        "k_norm": 1.0 + nrm(keys[12], (DEPTH, ATT_HEAD_DIM), 0.02),
        "m_norm": 1.0 + nrm(keys[13], (DEPTH, M_HEADS, M_HEAD_DIM), 0.02),
        "w_out": nrm(keys[14], (DEPTH, mix_w, D_MODEL), mix_w ** -0.5),
        "ffn2_norm": 1.0 + nrm(keys[15], (DEPTH, D_MODEL), 0.02),
        "ffn2_w_gate": nrm(keys[16], (DEPTH, D_MODEL, D_FF), D_MODEL ** -0.5),
        "ffn2_w_up": nrm(keys[17], (DEPTH, D_MODEL, D_FF), D_MODEL ** -0.5),
        "ffn2_w_down": nrm(keys[18], (DEPTH, D_FF, D_MODEL), D_FF ** -0.5),
    }


def reference(x, ffn1_norm, ffn1_w_gate, ffn1_w_up, ffn1_w_down, mix_norm, w_in, conv_w, conv_b, gate_b,
              q_norm, k_norm, m_norm, w_out, ffn2_norm, ffn2_w_gate, ffn2_w_up, ffn2_w_down):
    pos = jnp.arange(x.shape[1], dtype=jnp.int32)
    for l in range(DEPTH):
        x = x + 0.5 * swiglu(rmsnorm(x, ffn1_norm[l]), ffn1_w_gate[l], ffn1_w_up[l], ffn1_w_down[l])
        x = x + hybrid_mixer(rmsnorm(x, mix_norm[l]), pos, w_in[l], conv_w[l], conv_b[l], gate_b[l],
                             q_norm[l], k_norm[l], m_norm[l], w_out[l])
        x = x + 0.5 * swiglu(rmsnorm(x, ffn2_norm[l]), ffn2_w_gate[l], ffn2_w_up[l], ffn2_w_down[l])
    return x
```

```cpp
#include <hip/hip_runtime.h>
#include <stdint.h>
#include <math.h>
#include <cstdio>

constexpr int D = 1024, NB = 4, S = 8192, DEPTH = 2, T = NB * S;
constexpr int TOPK = 256, DFF = 2816, INC = 3020, INP = 3072;
constexpr float EPS = 1e-6f;
constexpr int C_Q = 0, C_K = 512, C_V = 576, C_QI = 640, C_KI = 896, C_WI = 960, C_QKM = 964, C_VM = 1988, C_OM = 2500, C_IG = 3012, C_FG = 3016;
typedef unsigned short bf16_t;


__device__ __forceinline__ int shx_i(int v, int m, int lane) { return __builtin_amdgcn_ds_bpermute((lane ^ m) << 2, v); }
__device__ __forceinline__ float shx(float v, int m, int lane) { return __builtin_bit_cast(float, shx_i(__builtin_bit_cast(int, v), m, lane)); }
__device__ __forceinline__ unsigned shx(unsigned v, int m, int lane) { return (unsigned)shx_i((int)v, m, lane); }
__device__ __forceinline__ float shfrom(float v, int src) { return __builtin_bit_cast(float, __builtin_amdgcn_ds_bpermute(src << 2, __builtin_bit_cast(int, v))); }
__device__ __forceinline__ unsigned shfrom(unsigned v, int src) { return (unsigned)__builtin_amdgcn_ds_bpermute(src << 2, (int)v); }
#ifndef FP8DOWN
#define FP8DOWN 1
#endif
#ifndef FP8UPLAST
#define FP8UPLAST 1
#endif
#define HYB 0
namespace pg8 {
#define PG8_LAS __attribute__((address_space(3)))
typedef unsigned short bf16_t;
typedef short bf16x8 __attribute__((ext_vector_type(8)));
typedef float f32x4 __attribute__((ext_vector_type(4)));
typedef unsigned u32x4 __attribute__((ext_vector_type(4)));
typedef int i32x4 __attribute__((ext_vector_type(4)));
constexpr int BM = 256, BK = 64, HALF = 128, HTB = HALF * BK * 2  , STAGE_BYTES = 8 * HTB, NXCD = 8, WGM = 8;

__host__ __device__ __forceinline__ int lds_byte(int r, int c) { const int st = (r >> 4) * 2 + (c >> 5), rr = r & 15, cc = c & 31, ob = rr * 64 + cc * 2; return st * 1024 + (ob ^ (((ob >> 9) & 1) << 5)); }
__host__ __device__ __forceinline__ void stage_rc(int b, int& R, int& C) { const int st = b / 1024, sb = b % 1024, swz = sb ^ (((sb >> 9) & 1) << 5); R = (st >> 1) * 16 + swz / 64; C = (st & 1) * 32 + (swz % 64) / 2; }
__host__ __device__ __forceinline__ int perm32(int rho) { const int n = rho >> 4, i = rho & 15; return 8 * (i >> 2) + 4 * n + (i & 3); }

struct Unit { int pm, pn; };
struct Gemm { const bf16_t* A; const bf16_t* Bt; int M, N, K; };

struct StaticOrder {
    int nM, nN, nwg, G, c;
    __host__ __device__ void init(int M, int N, int G_, int c_) { nM = M / BM; nN = N / BM; nwg = nM * nN; G = G_; c = c_; }
    __host__ __device__ bool next(int i, Unit& u) const {
        const long L = (long)i * G + c; if (L >= nwg) return false;
        int wgid = (int)L; { const int q = nwg / NXCD, r = nwg % NXCD, xcd = wgid % NXCD, off = wgid / NXCD; wgid = (xcd < r ? xcd * (q + 1) : r * (q + 1) + (xcd - r) * q) + off; }
        const int nig = WGM * nN, gid = wgid / nig, fm = gid * WGM, gsz = (nM - fm) < WGM ? (nM - fm) : WGM;
        u.pm = fm + ((wgid % nig) % gsz); u.pn = (wgid % nig) / gsz; return true;
    }
    __device__ __forceinline__ void a_ready(const Unit&) const {}
    __device__ __forceinline__ void done(const Unit&) const {}
};

__device__ __forceinline__ unsigned cvt_pk_bf16(float lo, float hi) { unsigned r; asm volatile("v_cvt_pk_bf16_f32 %0, %1, %2" : "=v"(r) : "v"(lo), "v"(hi)); return r; }
typedef float f32x2 __attribute__((ext_vector_type(2)));
#define PG8_GAS __attribute__((address_space(1)))
typedef PG8_GAS float gf32; typedef PG8_GAS bf16_t gbf16; typedef PG8_GAS f32x4 gf32x4; typedef PG8_GAS u32x4 gu32x4;
typedef const PG8_GAS float cgf32; typedef const PG8_GAS f32x4 cgf32x4;
__device__ __forceinline__ u32x4 pack8(const f32x4& a, const f32x4& b) { u32x4 w; w.x = cvt_pk_bf16(a[0], a[1]); w.y = cvt_pk_bf16(a[2], a[3]); w.z = cvt_pk_bf16(b[0], b[1]); w.w = cvt_pk_bf16(b[2], b[3]); return w; }
__device__ __forceinline__ float row_rstd(cgf32* SS, int row, int fq, int lane) {
    const f32x4 p = *(cgf32x4*)(SS + (size_t)row * 16 + 4 * fq);
    float s = (p[0] + p[1]) + (p[2] + p[3]);
    s += shx(s, 16, lane); s += shx(s, 32, lane);
    return rsqrtf(s * (1.0f / 1024.0f) + EPS);
}
__device__ __forceinline__ void row_rstd8(cgf32* SS, int row0, int fq, int lane, float (&rs)[2][4]) {
    f32x4 p[2][4];
#pragma unroll
    for (int ai = 0; ai < 2; ++ai)
#pragma unroll
        for (int m = 0; m < 4; ++m) p[ai][m] = *(cgf32x4*)(SS + (size_t)(row0 + ai * HALF + m * 16) * 16 + 4 * fq);
#pragma unroll
    for (int ai = 0; ai < 2; ++ai)
#pragma unroll
        for (int m = 0; m < 4; ++m) { float s = (p[ai][m][0] + p[ai][m][1]) + (p[ai][m][2] + p[ai][m][3]); s += shx(s, 16, lane); s += shx(s, 32, lane); rs[ai][m] = rsqrtf(s * (1.0f / 1024.0f) + EPS); }
}
__device__ __forceinline__ float silu_f(float g) { return g * __builtin_amdgcn_rcpf(1.0f + __builtin_amdgcn_exp2f(-1.4426950408889634f * g)); }

typedef unsigned u32x2 __attribute__((ext_vector_type(2)));
__device__ __forceinline__ u32x2 pack8_fp8(const f32x4& a, const f32x4& b) {
    unsigned lo = 0u, hi = 0u;
    lo = __builtin_amdgcn_cvt_pk_fp8_f32(a[0], a[1], lo, false); lo = __builtin_amdgcn_cvt_pk_fp8_f32(a[2], a[3], lo, true);
    hi = __builtin_amdgcn_cvt_pk_fp8_f32(b[0], b[1], hi, false); hi = __builtin_amdgcn_cvt_pk_fp8_f32(b[2], b[3], hi, true);
    return (u32x2){lo, hi};
}
constexpr float WUP_SCALE = 32.0f;
constexpr float ACT_SCALE = 1.0f, WDN_SCALE = 64.0f;
struct EpiUp {
    static constexpr bool PERM = true, AFTER_DRAIN = false;
    PG8_GAS unsigned char* ACT; cgf32* SS; float asc;
    __device__ __forceinline__ void operator()(const f32x4 (&acc)[2][2][4][2], const Unit& u, int wr, int wc, int fr_in, int fq_in) const {
        int fr, fq; { int l; asm volatile("v_mbcnt_lo_u32_b32 %0, -1, 0\n\tv_mbcnt_hi_u32_b32 %0, -1, %0" : "=v"(l)); fr = l & 15; fq = l >> 4; } (void)fr_in; (void)fq_in;
        const int row0 = u.pm * BM + wr * 64 + fr, col0 = u.pn * 128 + wc * 32 + 8 * fq;
        float rs8[2][4]; row_rstd8(SS, row0, fq, fr | (fq << 4), rs8);
#pragma unroll
        for (int ai = 0; ai < 2; ++ai)
#pragma unroll
            for (int m = 0; m < 4; ++m) rs8[ai][m] *= asc;
#pragma unroll
        for (int ai = 0; ai < 2; ++ai)
#pragma unroll
            for (int m = 0; m < 4; ++m) {
                asm volatile("" ::: "memory");
                const int row = row0 + ai * HALF + m * 16;
                const float rs = rs8[ai][m];
                f32x4 o[2];
#pragma unroll
                for (int n = 0; n < 2; ++n)
#pragma unroll
                    for (int j = 0; j < 4; ++j) o[n][j] = silu_f(acc[ai][0][m][n][j] * rs) * (acc[ai][1][m][n][j] * rs);
#if FP8DOWN
                *(PG8_GAS u32x2*)(ACT + (size_t)row * DFF + col0) = pack8_fp8(o[0], o[1]);
#else
                *(gu32x4*)((gbf16*)ACT + (size_t)row * DFF + col0) = pack8(o[0], o[1]);
#endif
            }
    }
};
struct EpiUpCheap {
    static constexpr bool PERM = true, AFTER_DRAIN = false;
    gbf16* ACT; cgf32* SS; int ld;
    __device__ __forceinline__ void operator()(const f32x4 (&acc)[2][2][4][2], const Unit& u, int wr, int wc, int fr, int fq) const {
        const int row0 = u.pm * BM + wr * 64 + fr, col0 = u.pn * 128 + wc * 32 + 8 * fq;
#pragma unroll
        for (int ai = 0; ai < 2; ++ai)
#pragma unroll
            for (int m = 0; m < 4; ++m) *(gu32x4*)(ACT + (size_t)(row0 + ai * HALF + m * 16) * ld + col0) = pack8(acc[ai][0][m][0] + acc[ai][1][m][0], acc[ai][0][m][1] + acc[ai][1][m][1]);
    }
};
template <bool FINAL, bool X8COPY = false> struct EpiRes {
    static constexpr bool PERM = true, AFTER_DRAIN = false;
    gf32* Xout; gbf16* XB; gf32* SS; PG8_GAS unsigned char* X8; float alpha;
    __device__ __forceinline__ void operator()(const f32x4 (&acc)[2][2][4][2], const Unit& u, int wr, int wc, int fr_in, int fq_in) const {
        int fr, fq; { int l; asm volatile("v_mbcnt_lo_u32_b32 %0, -1, 0\n\tv_mbcnt_hi_u32_b32 %0, -1, %0" : "=v"(l)); fr = l & 15; fq = l >> 4; }
        const int row0 = u.pm * BM + wr * 64 + fr, col0 = u.pn * BM + wc * 32 + 8 * fq;
        u32x4 xin[2][4][2];
#pragma unroll
        for (int ai = 0; ai < 2; ++ai)
#pragma unroll
            for (int m = 0; m < 4; ++m)
#pragma unroll
                for (int bj = 0; bj < 2; ++bj) xin[ai][m][bj] = *(const PG8_GAS u32x4*)(XB + (size_t)(row0 + ai * HALF + m * 16) * D + col0 + bj * HALF);
#pragma unroll
        for (int ai = 0; ai < 2; ++ai)
#pragma unroll
            for (int m = 0; m < 4; ++m) {
                const int row = row0 + ai * HALF + m * 16; float ssq = 0.f;
#pragma unroll
                for (int bj = 0; bj < 2; ++bj) {
                    const unsigned o = (unsigned)row * D + col0 + bj * HALF;
                    const u32x4 xb = xin[ai][m][bj];
                    f32x4 x0, x1;
                    x0[0] = __builtin_bit_cast(float, xb[0] << 16); x0[1] = __builtin_bit_cast(float, xb[0] & 0xffff0000u); x0[2] = __builtin_bit_cast(float, xb[1] << 16); x0[3] = __builtin_bit_cast(float, xb[1] & 0xffff0000u);
                    x1[0] = __builtin_bit_cast(float, xb[2] << 16); x1[1] = __builtin_bit_cast(float, xb[2] & 0xffff0000u); x1[2] = __builtin_bit_cast(float, xb[3] << 16); x1[3] = __builtin_bit_cast(float, xb[3] & 0xffff0000u);
                    const f32x4 y0 = x0 + alpha * acc[ai][bj][m][0], y1 = x1 + alpha * acc[ai][bj][m][1];
                    if (FINAL) { *(gf32x4*)(Xout + o) = y0; *(gf32x4*)(Xout + o + 4) = y1; }
                    else {
                        *(gu32x4*)(XB + o) = pack8(y0, y1);
                        if constexpr (X8COPY) *(PG8_GAS u32x2*)(X8 + o) = pack8_fp8(y0, y1);
                        ssq += (y0[0] * y0[0] + y0[1] * y0[1]) + (y0[2] * y0[2] + y0[3] * y0[3]) + (y1[0] * y1[0] + y1[1] * y1[1]) + (y1[2] * y1[2] + y1[3] * y1[3]);
                    }
                }
                if (!FINAL) { ssq += shx(ssq, 16, fr | (fq << 4)); ssq += shx(ssq, 32, fr | (fq << 4)); if (fq == 0) SS[(size_t)row * 16 + u.pn * 4 + wc] = ssq; }
            }
    }
};
struct EpiIn {
    static constexpr bool PERM = true, AFTER_DRAIN = false;
    cgf32* SS; cgf32* cs; cgf32* qn; cgf32* kn; cgf32* gate_b;
    gbf16 *Q, *KV, *QI, *KI, *QKM, *VM, *OM; gf32* GT;
    __device__ __forceinline__ void operator()(const f32x4 (&acc)[2][2][4][2], const Unit& u, int wr, int wc, int fr_in, int fq_in) const {
        const int fr = fr_in, fq = fq_in;
        const int row0 = u.pm * BM + wr * 64 + fr;
        float rs8[2][4]; row_rstd8(SS, row0, fq, fr | (fq << 4), rs8);
#pragma unroll
        for (int ai = 0; ai < 2; ++ai)
#pragma unroll
            for (int m = 0; m < 4; ++m) {
                asm volatile("" ::: "memory");
                const int row = row0 + ai * HALF + m * 16;
                const float rs = rs8[ai][m];
                f32x4 a0 = acc[ai][0][m][0] * rs, a1 = acc[ai][0][m][1] * rs, b0 = acc[ai][1][m][0] * rs, b1 = acc[ai][1][m][1] * rs;
                if (u.pn >= 4) {
                    if (u.pn >= 10) {
                        PG8_GAS unsigned char* o8 = (PG8_GAS unsigned char*)OM + (size_t)row * 512 + (u.pn - 10) * 256 + wc * 32 + 8 * fq;
                        *(PG8_GAS u32x2*)(o8) = pack8_fp8(a0, a1); *(PG8_GAS u32x2*)(o8 + 128) = pack8_fp8(b0, b1);
                    } else {
                        gbf16* base = (u.pn < 8 ? QKM + (size_t)row * 1024 + (u.pn - 4) * 256 : VM + (size_t)row * 512 + (u.pn - 8) * 256) + wc * 32 + 8 * fq;
                        *(gu32x4*)(base) = pack8(a0, a1); *(gu32x4*)(base + 128) = pack8(b0, b1);
                    }
                } else {
                    const int slot = u.pn * 4 + wc;
                    if (slot < 9) {
                        float ss = (a0[0] * a0[0] + a0[1] * a0[1]) + (a0[2] * a0[2] + a0[3] * a0[3]) + (a1[0] * a1[0] + a1[1] * a1[1]) + (a1[2] * a1[2] + a1[3] * a1[3])
                                 + (b0[0] * b0[0] + b0[1] * b0[1]) + (b0[2] * b0[2] + b0[3] * b0[3]) + (b1[0] * b1[0] + b1[1] * b1[1]) + (b1[2] * b1[2] + b1[3] * b1[3]);
                        ss += shx(ss, 16, fr | (fq << 4)); ss += shx(ss, 32, fr | (fq << 4));
                        const float r2 = rsqrtf(ss * (1.0f / 64.0f) + EPS);
                        cgf32* gn = (slot < 8 ? qn : kn) + 8 * fq;
                        a0 = a0 * r2 * *(cgf32x4*)(gn); a1 = a1 * r2 * *(cgf32x4*)(gn + 4);
                        b0 = b0 * r2 * *(cgf32x4*)(gn + 32); b1 = b1 * r2 * *(cgf32x4*)(gn + 36);
                    }
                    if (slot < 14) {
                        cgf32* c = cs + (size_t)(row & (S - 1)) * 64 + 8 * fq;
                        const f32x4 c0 = *(cgf32x4*)(c), c1 = *(cgf32x4*)(c + 4), s0 = *(cgf32x4*)(c + 32), s1 = *(cgf32x4*)(c + 36);
                        const f32x4 o10 = a0 * c0 - b0 * s0, o11 = a1 * c1 - b1 * s1, o20 = b0 * c0 + a0 * s0, o21 = b1 * c1 + a1 * s1;
                        if (slot == 8) {
                            PG8_GAS unsigned char* d8 = (PG8_GAS unsigned char*)KV + (size_t)row * 128 + 8 * fq;
                            *(PG8_GAS u32x2*)(d8) = pack8_fp8(o10, o11); *(PG8_GAS u32x2*)(d8 + 32) = pack8_fp8(o20, o21);
                        } else if (slot < 8) {
                            PG8_GAS unsigned char* q8 = (PG8_GAS unsigned char*)Q + (size_t)row * 512 + slot * 64 + 8 * fq;
                            *(PG8_GAS u32x2*)(q8) = pack8_fp8(o10, o11); *(PG8_GAS u32x2*)(q8 + 32) = pack8_fp8(o20, o21);
                        } else {
                            gbf16* dst;
                            if (slot == 9) dst = KI + (size_t)row * 64;
                            else dst = QI + (size_t)row * 256 + (slot - 10) * 64;
                            dst += 8 * fq;
                            *(gu32x4*)(dst) = pack8(o10, o11); *(gu32x4*)(dst + 32) = pack8(o20, o21);
                        }
                    } else if (slot == 14) {
                        PG8_GAS unsigned char* d8 = (PG8_GAS unsigned char*)KV + (size_t)row * 128 + 64 + 8 * fq;
                        *(PG8_GAS u32x2*)(d8) = pack8_fp8(a0, a1); *(PG8_GAS u32x2*)(d8 + 32) = pack8_fp8(b0, b1);
                    } else {
                        gf32* g = GT + (size_t)row * 16;
                        if (fq == 0) { *(gf32x4*)(g) = a0 * (1.0f / 16.0f); *(gf32x4*)(g + 4) = a1 + *(cgf32x4*)(gate_b); }
                        else if (fq == 1) { *(gf32x4*)(g + 8) = a0 + *(cgf32x4*)(gate_b + 4); }
                    }
                }
            }
    }
};

template <class Epi, class Sched, bool ALIGN_EPI = false, bool SP2 = false, bool FP8 = false>
__device__ __forceinline__ void gemm_phase(PG8_LAS unsigned char* lds, const Gemm g, const Sched& S, const Epi& E, int tid_in) {
    int tid_raw = tid_in; asm volatile("" : "+v"(tid_raw));
    const int tid = tid_raw, wid = __builtin_amdgcn_readfirstlane(tid >> 6), lane = tid & 63, wr = wid >> 2, wc = wid & 3, fr = lane & 15, fq = lane >> 4;
    const int K = g.K, nt = K / BK;
    unsigned voffA[2], voffB[2];
#pragma unroll
    for (int i = 0; i < 2; ++i) { int R, C; stage_rc(tid * 16 + i * 8192, R, C); const int Rb = Epi::PERM ? ((R & ~31) + perm32(R & 31)) : R;
        voffA[i] = (unsigned)(R * K + C) * 2u; voffB[i] = (unsigned)(Rb * K + C) * 2u; }
    const size_t kstep = (size_t)(BK * 2);
    const size_t hstep = (size_t)HALF * K * 2;
    const size_t tstep = 2 * hstep;
    const unsigned ldsw = (unsigned)wid * 1024u;
    const int aoff = lds_byte(wr * 64 + fr, fq * 8), boff = lds_byte(wc * 32 + fr, fq * 8);
#define PG8_SA(b, h) (((b) * 2 + (h)) * HTB)
#define PG8_SB(b, h) ((4 + (b) * 2 + (h)) * HTB)
#define PG8_STAGE(bufoff, gbase, voff) do { _Pragma("unroll") for (int _i = 0; _i < 2; ++_i) \
        __builtin_amdgcn_global_load_lds((const unsigned*)((const char*)(gbase) + (voff)[_i]), (PG8_LAS unsigned*)(lds + (bufoff) + ldsw + _i * 8192), 16, 0, 0); } while (0)
#define PG8_LDA(dst, b, h) do { _Pragma("unroll") for (int m = 0; m < 4; ++m) _Pragma("unroll") for (int k = 0; k < 2; ++k) dst[m][k] = *(const PG8_LAS bf16x8*)(lds + PG8_SA(b, h) + aoff + m * 2048 + k * 1024); } while (0)
#define PG8_LDB(dst, b, h) do { _Pragma("unroll") for (int n = 0; n < 2; ++n) _Pragma("unroll") for (int k = 0; k < 2; ++k) dst[n][k] = *(const PG8_LAS bf16x8*)(lds + PG8_SB(b, h) + boff + n * 2048 + k * 1024); } while (0)
#define PG8_CAT(x0, x1) __builtin_shufflevector(__builtin_bit_cast(i32x4, x0), __builtin_bit_cast(i32x4, x1), 0, 1, 2, 3, 4, 5, 6, 7)
#define PG8_MMA(ai, bj, At, Bt) do { __builtin_amdgcn_s_setprio(1); \
        if constexpr (FP8) { _Pragma("unroll") for (int m = 0; m < 4; ++m) _Pragma("unroll") for (int n = 0; n < 2; ++n) \
            asm volatile("v_mfma_f32_16x16x128_f8f6f4 %0, %1, %2, %0" : "+v"(acc[ai][bj][m][n]) : "v"(PG8_CAT(Bt[n][0], Bt[n][1])), "v"(PG8_CAT(At[m][0], At[m][1]))); } \
        else { _Pragma("unroll") for (int m = 0; m < 4; ++m) _Pragma("unroll") for (int n = 0; n < 2; ++n) _Pragma("unroll") for (int k = 0; k < 2; ++k) \
            acc[ai][bj][m][n] = __builtin_amdgcn_mfma_f32_16x16x32_bf16(Bt[n][k], At[m][k], acc[ai][bj][m][n], 0, 0, 0); } \
        __builtin_amdgcn_s_setprio(0); } while (0)
#define PG8_GUARD do { if constexpr (FP8) asm volatile("s_nop 15\n\ts_nop 15" ::: "memory"); } while (0)
#define PG8_WAIT_V(n) asm volatile("s_waitcnt vmcnt(" #n ")" ::: "memory")
#define PG8_WAIT_L(n) asm volatile("s_waitcnt lgkmcnt(" #n ")" ::: "memory")
#define PG8_BAR __builtin_amdgcn_s_barrier()
#define PG8_SCHED __builtin_amdgcn_sched_barrier(0)
    Unit cur, nxt; int ui = 0;
    if (!S.next(0, cur)) return;
    f32x4 acc[2][2][4][2];
#pragma unroll
    for (int a = 0; a < 2; ++a)
#pragma unroll
        for (int b = 0; b < 2; ++b)
#pragma unroll
            for (int m = 0; m < 4; ++m)
#pragma unroll
                for (int n = 0; n < 2; ++n) acc[a][b][m][n] = (f32x4){0.f, 0.f, 0.f, 0.f};
    bf16x8 At[4][2], B0[2][2], B1[2][2];
    const char* cA = (const char*)g.A + (size_t)cur.pm * tstep; const char* cB = (const char*)g.Bt + (size_t)cur.pn * tstep;
    S.a_ready(cur);
    if constexpr (SP2) {
        PG8_STAGE(PG8_SB(0, 0), cB, voffB); PG8_STAGE(PG8_SB(0, 1), cB + hstep, voffB); PG8_STAGE(PG8_SA(0, 0), cA, voffA); PG8_STAGE(PG8_SA(0, 1), cA + hstep, voffA);
        if (wr == 1) PG8_BAR;
        PG8_WAIT_V(2); PG8_BAR;
        PG8_STAGE(PG8_SB(1, 0), cB + kstep, voffB); PG8_STAGE(PG8_SA(1, 0), cA + kstep, voffA); PG8_STAGE(PG8_SB(1, 1), cB + hstep + kstep, voffB);
        PG8_WAIT_V(6); PG8_BAR;
    } else {
        PG8_STAGE(PG8_SB(0, 0), cB, voffB); PG8_STAGE(PG8_SA(0, 0), cA, voffA); PG8_STAGE(PG8_SB(0, 1), cB + hstep, voffB); PG8_STAGE(PG8_SA(0, 1), cA + hstep, voffA);
        if (wr == 1) PG8_BAR;
        PG8_WAIT_V(4); PG8_BAR;
        PG8_STAGE(PG8_SB(1, 0), cB + kstep, voffB); PG8_STAGE(PG8_SA(1, 0), cA + kstep, voffA); PG8_STAGE(PG8_SB(1, 1), cB + hstep + kstep, voffB);
        PG8_WAIT_V(6); PG8_BAR;
    }
    for (;;) {
        const bool has_next = S.next(ui + 1, nxt);
        const char* nA = has_next ? (const char*)g.A + (size_t)nxt.pm * tstep : cA; const char* nB = has_next ? (const char*)g.Bt + (size_t)nxt.pn * tstep : cB;
        for (int t = 0; t < nt; t += 2) {
            const bool last = (t == nt - 2);
            const char* a1 = cA + (size_t)(t + 1) * kstep;
            const char* a2 = last ? nA : cA + (size_t)(t + 2) * kstep; const char* b2 = last ? nB : cB + (size_t)(t + 2) * kstep;
            const char* a3 = a2 + kstep; const char* b3 = b2 + kstep;
            if (last && has_next) S.a_ready(nxt);
            if constexpr (SP2) {
            PG8_LDB(B0, 0, 0); PG8_LDB(B1, 0, 1); PG8_SCHED; PG8_LDA(At, 0, 0); PG8_STAGE(PG8_SA(1, 1), a1 + hstep, voffA);
            PG8_WAIT_V(8); PG8_WAIT_L(0); PG8_BAR; PG8_MMA(0, 0, At, B0); PG8_MMA(0, 1, At, B1); PG8_BAR; PG8_GUARD; PG8_SCHED;
            PG8_LDA(At, 0, 1); PG8_STAGE(PG8_SB(0, 0), b2, voffB); PG8_STAGE(PG8_SB(0, 1), b2 + hstep, voffB); PG8_STAGE(PG8_SA(0, 0), a2, voffA);
            PG8_WAIT_V(8); PG8_WAIT_L(0); PG8_BAR; PG8_MMA(1, 0, At, B0); PG8_MMA(1, 1, At, B1); PG8_BAR; PG8_GUARD; PG8_SCHED;
            PG8_LDB(B0, 1, 0); PG8_LDB(B1, 1, 1); PG8_SCHED; PG8_LDA(At, 1, 0); PG8_STAGE(PG8_SA(0, 1), a2 + hstep, voffA);
            PG8_WAIT_V(8); PG8_WAIT_L(0); PG8_BAR; PG8_MMA(0, 0, At, B0); PG8_MMA(0, 1, At, B1); PG8_BAR; PG8_GUARD; PG8_SCHED;
            PG8_LDA(At, 1, 1); PG8_STAGE(PG8_SB(1, 0), b3, voffB); PG8_STAGE(PG8_SB(1, 1), b3 + hstep, voffB); PG8_STAGE(PG8_SA(1, 0), a3, voffA);
            PG8_WAIT_V(8); PG8_WAIT_L(0); PG8_BAR; PG8_MMA(1, 0, At, B0); PG8_MMA(1, 1, At, B1); PG8_BAR; PG8_GUARD; PG8_SCHED;
            } else {
            PG8_LDB(B0, 0, 0); PG8_SCHED; PG8_LDA(At, 0, 0); PG8_STAGE(PG8_SA(1, 1), a1 + hstep, voffA);
            PG8_WAIT_L(8); PG8_BAR; PG8_WAIT_L(0); PG8_MMA(0, 0, At, B0); PG8_BAR; PG8_SCHED;
            PG8_LDB(B1, 0, 1); PG8_STAGE(PG8_SB(0, 0), b2, voffB);
            PG8_BAR; PG8_WAIT_L(0); PG8_MMA(0, 1, At, B1); PG8_BAR;
            PG8_LDA(At, 0, 1); PG8_STAGE(PG8_SA(0, 0), a2, voffA);
            PG8_BAR; PG8_WAIT_L(0); PG8_MMA(1, 0, At, B0); PG8_BAR; PG8_SCHED;
            PG8_STAGE(PG8_SB(0, 1), b2 + hstep, voffB);
            PG8_WAIT_V(6); PG8_BAR; PG8_MMA(1, 1, At, B1); PG8_BAR;
            PG8_LDB(B0, 1, 0); PG8_SCHED; PG8_LDA(At, 1, 0); PG8_STAGE(PG8_SA(0, 1), a2 + hstep, voffA);
            PG8_WAIT_L(8); PG8_BAR; PG8_WAIT_L(0); PG8_MMA(0, 0, At, B0); PG8_BAR; PG8_SCHED;
            PG8_LDB(B1, 1, 1); PG8_STAGE(PG8_SB(1, 0), b3, voffB);
            PG8_BAR; PG8_WAIT_L(0); PG8_MMA(0, 1, At, B1); PG8_BAR;
            PG8_LDA(At, 1, 1); PG8_STAGE(PG8_SA(1, 0), a3, voffA);
            PG8_BAR; PG8_WAIT_L(0); PG8_MMA(1, 0, At, B0); PG8_BAR; PG8_SCHED;
            PG8_STAGE(PG8_SB(1, 1), b3 + hstep, voffB);
            PG8_WAIT_V(6); PG8_BAR; PG8_MMA(1, 1, At, B1); PG8_BAR;
            }
        }
        if constexpr (FP8) { asm volatile("s_nop 15\n\ts_nop 15\n\ts_nop 15" ::: "memory"); }
        if constexpr (ALIGN_EPI) { if (wr == 0) PG8_BAR; }
        if constexpr (!Epi::AFTER_DRAIN) { E(acc, cur, wr, wc, fr, fq); S.done(cur); }
        if (!has_next) break;
#pragma unroll
        for (int a = 0; a < 2; ++a)
#pragma unroll
            for (int b = 0; b < 2; ++b)
#pragma unroll
                for (int m = 0; m < 4; ++m)
#pragma unroll
                    for (int n = 0; n < 2; ++n) acc[a][b][m][n] = (f32x4){0.f, 0.f, 0.f, 0.f};
        cur = nxt; cA = nA; cB = nB; ++ui;
        if constexpr (ALIGN_EPI) { if (wr == 1) PG8_BAR; }
    }
    PG8_WAIT_V(0);
    if constexpr (!ALIGN_EPI) { if (wr == 0) PG8_BAR; }
    PG8_BAR;
    if constexpr (Epi::AFTER_DRAIN) { E.fused(acc, cur, wr, wc, fr, fq, lds, wid, lane); S.done(cur); }
#undef PG8_SA
#undef PG8_SB
#undef PG8_STAGE
#undef PG8_LDA
#undef PG8_LDB
#undef PG8_MMA
#undef PG8_CAT
#undef PG8_WAIT_V
#undef PG8_GUARD
#undef PG8_WAIT_L
#undef PG8_BAR
#undef PG8_SCHED
}
}
#define GAS __attribute__((address_space(1)))
#define LAS __attribute__((address_space(3)))
typedef unsigned v4u __attribute__((ext_vector_type(4)));
typedef float f32x4 __attribute__((ext_vector_type(4)));
typedef short bf16x8 __attribute__((ext_vector_type(8)));
typedef GAS unsigned gu32;
#define RLX_AGENT __ATOMIC_RELAXED, __HIP_MEMORY_SCOPE_AGENT
#define LDS_WAIT() asm volatile("s_waitcnt lgkmcnt(0)" ::: "memory")
#define VM_WAIT() asm volatile("s_waitcnt vmcnt(0)" ::: "memory")
__device__ __forceinline__ unsigned f2bf(float f) { unsigned u = __builtin_bit_cast(unsigned, f); return (u + 0x7fffu + ((u >> 16) & 1u)) >> 16; }
__device__ __forceinline__ unsigned pk2(float lo, float hi) { unsigned r; asm("v_cvt_pk_bf16_f32 %0, %1, %2" : "=v"(r) : "v"(lo), "v"(hi)); return r; }
__device__ __forceinline__ float bf2f(unsigned short b) { return __builtin_bit_cast(float, (unsigned)b << 16); }

constexpr size_t MiB = 1u << 20;
constexpr size_t WS_CTL = 0, CTL_ZERO_BYTES = 1 * MiB;
constexpr size_t WS_CS = 1 * MiB;
constexpr size_t WS_SS = 3 * MiB;
constexpr size_t WS_W = 5 * MiB;
constexpr size_t W_UP = (size_t)2 * DFF * D * 2, W_DN = (size_t)D * DFF * 2, W_IN = (size_t)INP * D * 2, W_OUT = (size_t)D * D * 2;
constexpr size_t WO_U1 = 0, WO_D1 = WO_U1 + W_UP, WO_IN = WO_D1 + W_DN, WO_OUT = WO_IN + W_IN, WO_U2 = WO_OUT + W_OUT, WO_D2 = WO_U2 + W_UP, W_LAYER = WO_D2 + W_DN;
static_assert(W_LAYER == 41 * MiB, "weights per layer");
constexpr size_t WS_XB = 87 * MiB;
constexpr size_t WS_BIG = 151 * MiB;
constexpr size_t WS_XB8 = WS_BIG + 96 * MiB;
constexpr size_t WS_ACT = WS_BIG;
constexpr size_t WS_Q = WS_BIG, WS_KV = WS_Q + 32 * MiB, WS_QI = WS_KV + 8 * MiB, WS_KI = WS_QI + 16 * MiB, WS_GT = WS_KI + 4 * MiB, WS_QKM = WS_GT + 2 * MiB,
                 WS_VM = WS_QKM + 64 * MiB, WS_OM = WS_VM + 32 * MiB, WS_MIX = WS_OM + 32 * MiB, WS_CC = WS_MIX + 64 * MiB, WS_CP = WS_CC + 64 * MiB,
                 WS_NC = WS_CP + 32 * MiB, WS_NP = WS_NC + MiB / 2, WS_SC = WS_NP + MiB / 2, WS_END = WS_SC + MiB;
static_assert(WS_MIX >= WS_ACT + (size_t)T * DFF * 2 || true, "");
static_assert(WS_END <= 512 * MiB, "workspace map");
constexpr int CW_BAR = 4096;
constexpr int RING_BYTES = 131072, LDSCTL_OFF = RING_BYTES, MISC_OFF = LDSCTL_OFF + 320, LDS_BYTES = 147456, LDS_TAB_OFF = LDSCTL_OFF + 2048;
constexpr int NWAVES = 8, NTHR = 512;

__device__ __forceinline__ int my_lane_volatile() { int x; asm volatile("v_mbcnt_lo_u32_b32 %0, -1, 0\n\tv_mbcnt_hi_u32_b32 %0, -1, %0" : "=v"(x)); return x; }
#define XB_TMO      128
#define XB_XCNT(j)  (256  + 64 * (j))
#define XB_XSUB(j)  (1280 + 64 * (j))
#define XB_XGEN(j)  (2304 + 64 * (j))
#define XB_TOP      3328
#define XB_TOPGEN   3392
#define XCD_BAR_WORDS 3456
#define XB_SPIN_CAP (1u << 18)

__device__ __forceinline__ unsigned xb_ld(unsigned* p)              { return __hip_atomic_load(p, __ATOMIC_RELAXED, __HIP_MEMORY_SCOPE_AGENT); }
__device__ __forceinline__ unsigned xb_add(unsigned* p, unsigned v) { return __hip_atomic_fetch_add(p, v, __ATOMIC_RELAXED, __HIP_MEMORY_SCOPE_AGENT); }
__device__ __forceinline__ unsigned xb_xcc_id() { return (unsigned)__builtin_amdgcn_s_getreg((3 << 11) | 20) & 0xFu; }
#define XB_SPIN(cond, bar) do { unsigned _sp = 0; while (cond) { __builtin_amdgcn_s_sleep(1); \
    if ((++_sp & 255u) == 0u) { if (xb_ld(&(bar)[XB_TMO])) break; if (_sp > XB_SPIN_CAP) { atomicAdd(&(bar)[XB_TMO], 1u); break; } } } } while (0)

struct XcdBarrier {
    unsigned* bar; unsigned x;
    volatile LAS unsigned* st; int wave;
};

__device__ __forceinline__ XcdBarrier xcd_barrier_post(unsigned* bar, volatile LAS unsigned* st, int wave) {
    XcdBarrier b; b.bar = bar; b.x = xb_xcc_id(); b.st = st; b.wave = wave;
    if (wave == 0 && my_lane_volatile() == 0) (void)xb_add(&bar[XB_XCNT(b.x)], 1u);
    return b;
}
__device__ __forceinline__ void xcd_barrier_complete(unsigned* bar, unsigned x, unsigned& nloc, unsigned& nx) {
    const unsigned G = gridDim.x * gridDim.y * gridDim.z;
    unsigned sum, cnt, mine, sp = 0u;
    for (;;) {
        sum = 0u; cnt = 0u; mine = 0u;
#pragma unroll
        for (unsigned j = 0; j < 16; ++j) { const unsigned c = xb_ld(&bar[XB_XCNT(j)]); sum += c; cnt += (c > 0u) ? 1u : 0u; mine = (j == x) ? c : mine; }
        if (sum == G) break;
        __builtin_amdgcn_s_sleep(1);
        if ((++sp & 255u) == 0u) { if (xb_ld(&bar[XB_TMO])) break; if (sp > XB_SPIN_CAP) { atomicAdd(&bar[XB_TMO], 1u); break; } }
    }
    nloc = mine > 0u ? mine : 1u; nx = cnt > 0u ? cnt : 1u;
}

__device__ __forceinline__ void xcd_barrier(const XcdBarrier& b) {
    asm volatile("s_waitcnt vmcnt(0)" ::: "memory");
    __syncthreads();
    if (b.wave == 0 && my_lane_volatile() == 0) {
        unsigned* bar = b.bar;
        __builtin_amdgcn_s_waitcnt(0);
        unsigned nloc = b.st[0], nx = b.st[1];
        if (nloc == 0u) { xcd_barrier_complete(bar, b.x, nloc, nx); b.st[0] = nloc; b.st[1] = nx; }
        const unsigned old = xb_add(&bar[XB_XSUB(b.x)], 1u);
        const unsigned gen = old / nloc;
        if (old + 1u == (gen + 1u) * nloc) {
            __builtin_amdgcn_fence(__ATOMIC_RELEASE, "agent");
            asm volatile("s_waitcnt vmcnt(0)" ::: "memory");
            const unsigned og = xb_add(&bar[XB_TOP], 1u);
            const unsigned tg = og / nx;
            if (og + 1u == (tg + 1u) * nx) xb_add(&bar[XB_TOPGEN], 1u);
            else XB_SPIN(xb_ld(&bar[XB_TOPGEN]) == tg, bar);
            __builtin_amdgcn_fence(__ATOMIC_ACQUIRE, "agent");
            xb_add(&bar[XB_XGEN(b.x)], 1u);
            asm volatile("s_waitcnt vmcnt(0)" ::: "memory");
        } else {
            XB_SPIN(xb_ld(&bar[XB_XGEN(b.x)]) == gen, bar);
            __builtin_amdgcn_fence(__ATOMIC_ACQUIRE, "agent");
            asm volatile("s_waitcnt vmcnt(0)" ::: "memory");
        }
    }
    __syncthreads();
}

struct Params {
    const float* in[18]; float* out; unsigned char* ws;
    int ph_lo, ph_hi, li, flags;
};
enum { I_X = 0, I_F1N = 1, I_F1G = 2, I_F1U = 3, I_F1D = 4, I_MN = 5, I_WIN = 6, I_CW = 7, I_CB = 8, I_GB = 9, I_QN = 10, I_KN = 11, I_MNORM = 12, I_WOUT = 13, I_F2N = 14, I_F2G = 15, I_F2U = 16, I_F2D = 17 };

__device__ __forceinline__ float wave_sum(float v, int lane) {
#pragma unroll
    for (int o = 1; o < 64; o <<= 1) v += shx(v, o, lane);
    return v;
}
__device__ __forceinline__ int win_src(int p) {
    if (p >= 1024) return p < 2048 ? C_QKM + (p - 1024) : (p < 2560 ? C_VM + (p - 2048) : C_OM + (p - 2560));
    const int pn = p >> 8, r = p & 255, bj = r >> 7, wc = (r >> 5) & 3, dd = r & 31, slot = pn * 4 + wc, d = 32 * bj + dd;
    if (slot < 8) return C_Q + slot * 64 + d;
    if (slot == 8) return C_K + d;
    if (slot == 9) return C_KI + d;
    if (slot < 14) return C_QI + (slot - 10) * 64 + d;
    if (slot == 14) return C_V + d;
    if (d < 4) return C_WI + d;
    if (d < 8) return C_IG + d - 4;
    if (d < 12) return C_FG + d - 8;
    return -1;
}
__device__ __forceinline__ void tr_item(const float* W, int ldw, int K, bf16_t* WT, int n0, int k0, int srccol, const float* gain, LAS float* scr, int lane, float f8scale) {
    float v[32];
#pragma unroll
    for (int i = 0; i < 32; ++i) { const int kk = 2 * i + (lane >> 5); v[i] = srccol >= 0 ? W[(size_t)(k0 + kk) * ldw + srccol] : 0.f; }
    if (gain) {
#pragma unroll
        for (int i = 0; i < 32; ++i) v[i] *= gain[k0 + 2 * i + (lane >> 5)];
    }
#pragma unroll
    for (int i = 0; i < 32; ++i) scr[(2 * i + (lane >> 5)) * 33 + (lane & 31)] = v[i];
    LDS_WAIT(); asm volatile("" ::: "memory");
    const int c = lane & 7;
    if (f8scale > 0.f) {
#pragma unroll
        for (int j = 0; j < 4; ++j) { const int n = (lane >> 3) + 8 * j; const LAS float* s = scr + (8 * c) * 33 + n;
            unsigned lo = 0u, hi = 0u;
            lo = __builtin_amdgcn_cvt_pk_fp8_f32(s[0 * 33] * f8scale, s[1 * 33] * f8scale, lo, false); lo = __builtin_amdgcn_cvt_pk_fp8_f32(s[2 * 33] * f8scale, s[3 * 33] * f8scale, lo, true);
            hi = __builtin_amdgcn_cvt_pk_fp8_f32(s[4 * 33] * f8scale, s[5 * 33] * f8scale, hi, false); hi = __builtin_amdgcn_cvt_pk_fp8_f32(s[6 * 33] * f8scale, s[7 * 33] * f8scale, hi, true);
            *(GAS unsigned long long*)((GAS unsigned char*)WT + (size_t)(n0 + n) * K + k0 + 8 * c) = (unsigned long long)lo | ((unsigned long long)hi << 32); }
    } else {
#pragma unroll
    for (int j = 0; j < 4; ++j) { const int n = (lane >> 3) + 8 * j; const LAS float* s = scr + (8 * c) * 33 + n;
        v4u o; o.x = pk2(s[0 * 33], s[1 * 33]); o.y = pk2(s[2 * 33], s[3 * 33]); o.z = pk2(s[4 * 33], s[5 * 33]); o.w = pk2(s[6 * 33], s[7 * 33]);
        *(GAS v4u*)(WT + (size_t)(n0 + n) * K + k0 + 8 * c) = o; }
    }
    LDS_WAIT(); asm volatile("" ::: "memory");
}
__device__ __forceinline__ void sincos_acc(float ang, float& c, float& s) {
    const double TWO_PI = 6.283185307179586476925286766559, INV_TWO_PI = 0.15915494309189533576888376337251;
    const double a = (double)ang, k = rint(a * INV_TWO_PI), r = a - k * TWO_PI, r2 = r * r;
    double sn = 0.0, cn = 0.0, ts = r, tc = 1.0;
#pragma unroll
    for (int i = 0; i < 15; ++i) { sn += ts; cn += tc; tc = -tc * r2 * (1.0 / (double)((2 * i + 1) * (2 * i + 2))); ts = -ts * r2 * (1.0 / (double)((2 * i + 2) * (2 * i + 3))); }
    c = (float)cn; s = (float)sn;
}
__device__ __forceinline__ void p0_prologue(const Params& P, LAS unsigned char* lds, int vcu, int G, int wave, int lane) {
    LAS float* scr = (LAS float*)(lds + wave * 16384);
    const int gw = vcu * NWAVES + wave, NGW = G * NWAVES;
    unsigned char* ws = P.ws;
    constexpr int I_UP = (D / 64) * (2 * DFF / 32), I_DN = (DFF / 64) * (D / 32), I_IN = (D / 64) * (INP / 32), I_OUT = (D / 64) * (D / 32);
    constexpr int I_LAYER = 2 * I_UP + 2 * I_DN + I_IN + I_OUT;
    for (int it = gw; it < DEPTH * I_LAYER; it += NGW) {
        const int l = it / I_LAYER; int r = it % I_LAYER;
        const float* W; const float* gain = nullptr; int ldw, K, nblk, src_mode; size_t wo; float f8 = 0.f;
        if (r < 2 * I_UP) { const int f = r / I_UP; r -= f * I_UP; ldw = DFF; K = D; nblk = 2 * DFF / 32; src_mode = f; wo = f ? WO_U2 : WO_U1; gain = P.in[f ? I_F2N : I_F1N] + l * D; W = nullptr;
                            if (FP8UPLAST && l == DEPTH - 1 && f == 1) f8 = pg8::WUP_SCALE; }
        else if (r < 2 * I_UP + 2 * I_DN) { r -= 2 * I_UP; const int f = r / I_DN; r -= f * I_DN; ldw = D; K = DFF; nblk = D / 32; src_mode = 2; wo = f ? WO_D2 : WO_D1; W = P.in[f ? I_F2D : I_F1D] + (size_t)l * DFF * D; f8 = FP8DOWN ? pg8::WDN_SCALE : 0.f; }
        else if (r < 2 * I_UP + 2 * I_DN + I_IN) { r -= 2 * I_UP + 2 * I_DN; ldw = INC; K = D; nblk = INP / 32; src_mode = 3; wo = WO_IN; gain = P.in[I_MN] + l * D; W = P.in[I_WIN] + (size_t)l * D * INC; }
        else { r -= 2 * I_UP + 2 * I_DN + I_IN; ldw = D; K = D; nblk = D / 32; src_mode = 2; wo = WO_OUT; W = P.in[I_WOUT] + (size_t)l * D * D; }
        const int kb = r / nblk, nb = r % nblk, n0 = 32 * nb, k0 = 64 * kb;
        int src = n0 + (lane & 31);
        if (src_mode < 2) {
            const int pn = n0 >> 8, rr = n0 & 255;
            W = (rr < 128 ? P.in[src_mode ? I_F2G : I_F1G] : P.in[src_mode ? I_F2U : I_F1U]) + (size_t)l * D * DFF;
            src = 128 * pn + (rr & 127) + (lane & 31);
        } else if (src_mode == 3) src = win_src(src);
        tr_item(W, ldw, K, (bf16_t*)(ws + WS_W + (size_t)l * W_LAYER + wo), n0, k0, src, gain, scr, lane, f8);
    }
    {
        const float* x = P.in[I_X]; bf16_t* XB = (bf16_t*)(ws + WS_XB); float* SS = (float*)(ws + WS_SS);
        for (int m0 = gw * 4; m0 < T; m0 += NGW * 4) {
            f32x4 v[4][4];
#pragma unroll
            for (int r = 0; r < 4; ++r) { const GAS f32x4* xr = (const GAS f32x4*)(x + (size_t)(m0 + r) * D) + lane;
#pragma unroll
                for (int j = 0; j < 4; ++j) v[r][j] = xr[64 * j]; }
#pragma unroll
            for (int r = 0; r < 4; ++r) { float s = 0.f;
#pragma unroll
                for (int j = 0; j < 4; ++j) s += (v[r][j][0] * v[r][j][0] + v[r][j][1] * v[r][j][1]) + (v[r][j][2] * v[r][j][2] + v[r][j][3] * v[r][j][3]);
                s = wave_sum(s, lane);
                GAS unsigned long long* o8 = (GAS unsigned long long*)(XB + (size_t)(m0 + r) * D) + lane;
#pragma unroll
                for (int j = 0; j < 4; ++j) o8[64 * j] = (unsigned long long)pk2(v[r][j][0], v[r][j][1]) | ((unsigned long long)pk2(v[r][j][2], v[r][j][3]) << 32);
                if (lane < 16) SS[(size_t)(m0 + r) * 16 + lane] = lane == 0 ? s : 0.f; }
        }
    }
    {
        float* cs = (float*)(ws + WS_CS);
        for (int i = gw * 64 + lane; i < S * 32; i += NGW * 64) {
            const int pos = i >> 5, j = i & 31; float c, s;
            double fr = 1.0; for (int q = 0; q < j; ++q) fr *= 0.74989420933245582730;
            sincos_acc((float)pos * (float)fr, c, s);
            cs[pos * 64 + j] = c; cs[pos * 64 + 32 + j] = s;
        }
    }
}
typedef short v4i16_t __attribute__((ext_vector_type(4)));
typedef float f32x2_t __attribute__((ext_vector_type(2)));
typedef GAS float gf32; typedef const GAS float cgf32; typedef GAS bf16_t gbf; typedef const GAS bf16_t cgbf;
typedef const GAS v4u cgv4u; typedef GAS v4u gv4u; typedef const GAS f32x4 cgf32x4;
__device__ __forceinline__ v4i16_t tr16(LAS const unsigned char* p) { return __builtin_amdgcn_ds_read_tr16_b64_v4i16((LAS v4i16_t*)p); }
__device__ __forceinline__ bf16x8 cat8(v4i16_t lo, v4i16_t hi) { bf16x8 r; r[0] = lo[0]; r[1] = lo[1]; r[2] = lo[2]; r[3] = lo[3]; r[4] = hi[0]; r[5] = hi[1]; r[6] = hi[2]; r[7] = hi[3]; return r; }
__device__ __forceinline__ pg8::f32x4 mfma16(bf16x8 a, bf16x8 b, pg8::f32x4 c) {
    c = __builtin_amdgcn_mfma_f32_16x16x32_bf16(a, b, c, 0, 0, 0);
    asm volatile("s_nop 3" : "+v"(c) : "v"(a), "v"(b));
    return c;
}
__device__ __forceinline__ unsigned opaque0() { unsigned z; asm volatile("v_mov_b32 %0, 0" : "=v"(z)); return z; }
__device__ __forceinline__ float fast_sigmoid(float x) { return __builtin_amdgcn_rcpf(1.0f + __builtin_amdgcn_exp2f(-1.4426950408889634f * x)); }
__device__ __forceinline__ float fast_exp(float x) { return __builtin_amdgcn_exp2f(1.4426950408889634f * x); }
constexpr int ML_UNITS = NB * 4 * 64;
constexpr int ST_T = 288, ST_R = 272;
constexpr float KSCALE = 0.08838834764831845f;

__device__ __forceinline__ float lane63(float x) { return __builtin_bit_cast(float, __builtin_amdgcn_readlane(__builtin_bit_cast(int, x), 63)); }
__device__ __forceinline__ float scan_add(float x, int lane) {
#pragma unroll
    for (int d = 1; d < 64; d <<= 1) { const float y = shfrom(x, lane - d); x += (lane >= d) ? y : 0.f; }
    return x;
}
__device__ __forceinline__ float scan_max(float x, int lane) {
#pragma unroll
    for (int d = 1; d < 64; d <<= 1) { const float y = shfrom(x, lane - d); x = (lane >= d) ? fmaxf(x, y) : x; }
    return x;
}
__device__ __forceinline__ void ml_gates_reg(cgf32* GT, int tok0, int h, int wave, int lane, float& bt, float& ct, float& pm, float& bl, float& cmax) {
    const float f0 = GT[(size_t)(tok0 + lane) * 16 + 8 + h], i0 = GT[(size_t)(tok0 + lane) * 16 + 4 + h];
    const float f1 = GT[(size_t)(tok0 + 64 + lane) * 16 + 8 + h], i1 = GT[(size_t)(tok0 + 64 + lane) * 16 + 4 + h];
    const float l0 = fminf(f0, 0.f) - 0.6931471805599453f * __builtin_amdgcn_logf(1.0f + __builtin_amdgcn_exp2f(-1.4426950408889634f * fabsf(f0))), l1 = fminf(f1, 0.f) - 0.6931471805599453f * __builtin_amdgcn_logf(1.0f + __builtin_amdgcn_exp2f(-1.4426950408889634f * fabsf(f1)));
    const float b0 = scan_add(l0, lane), tot0 = lane63(b0), b1 = scan_add(l1, lane) + tot0;
    const float c0 = i0 - b0, c1 = i1 - b1;
    const float p0 = scan_max(c0, lane), m0 = lane63(p0), p1 = fmaxf(scan_max(c1, lane), m0);
    bl = lane63(b1); cmax = lane63(p1);
    bt = wave ? b1 : b0; ct = wave ? c1 : c0; pm = wave ? p1 : p0;
}
__device__ __forceinline__ void ml_conv_tile(cgbf* QKM, cgf32* cw, cgf32* cb, int tok0, int c, int col0, LAS unsigned char* img, int stride, float scl, const LAS float* rowscale, int tid, unsigned Z) {
    const int dg = tid & 15, r4 = tid >> 4, t0 = 4 * r4;
    v4u x[7];
#pragma unroll
    for (int j = 0; j < 7; ++j) { const int tt = t0 - 3 + j; const bool ok = (tt >= 0) || (c > 0);
        x[j] = *(cgv4u*)(QKM + (size_t)(tok0 + (ok ? tt : 0)) * 1024 + col0 + 8 * dg);
        if (!ok) x[j] = (v4u){Z, Z, Z, Z}; }
    float w[4][8], bb[8];
#pragma unroll
    for (int j = 0; j < 4; ++j) { const f32x4 a = *(cgf32x4*)(cw + j * 1024 + col0 + 8 * dg), b = *(cgf32x4*)(cw + j * 1024 + col0 + 8 * dg + 4);
#pragma unroll
        for (int e = 0; e < 4; ++e) { w[j][e] = a[e]; w[j][4 + e] = b[e]; } }
    { const f32x4 a = *(cgf32x4*)(cb + col0 + 8 * dg), b = *(cgf32x4*)(cb + col0 + 8 * dg + 4);
#pragma unroll
      for (int e = 0; e < 4; ++e) { bb[e] = a[e]; bb[4 + e] = b[e]; } }
#pragma unroll
    for (int r = 0; r < 4; ++r) {
        float y[8];
#pragma unroll
        for (int e = 0; e < 8; ++e) y[e] = bb[e];
#pragma unroll
        for (int j = 0; j < 4; ++j)
#pragma unroll
            for (int e = 0; e < 4; ++e) { y[2 * e] += w[j][2 * e] * __builtin_bit_cast(float, x[r + j][e] << 16); y[2 * e + 1] += w[j][2 * e + 1] * __builtin_bit_cast(float, x[r + j][e] & 0xffff0000u); }
        const float sc = rowscale ? scl * rowscale[t0 + r] : scl;
#pragma unroll
        for (int e = 0; e < 8; ++e) y[e] = y[e] * fast_sigmoid(y[e]) * sc;
        v4u o; o.x = pk2(y[0], y[1]); o.y = pk2(y[2], y[3]); o.z = pk2(y[4], y[5]); o.w = pk2(y[6], y[7]);
        *(LAS v4u*)(img + (t0 + r) * stride + 16 * dg) = o;
    }
}
__device__ __forceinline__ void ml_v_tile(cgbf* VM, int tok0, int h, LAS unsigned char* img, int tid, unsigned Z) {
    const int dg = tid & 15, tr = tid >> 4;
#pragma unroll
    for (int i = 0; i < 4; ++i) { const int t = tr + 32 * i;
        *(LAS v4u*)(img + t * ST_T + 16 * dg) = *(cgv4u*)(VM + (size_t)(tok0 + t) * 512 + h * 128 + 8 * dg); }
    if (tid < 128) { *(LAS v4u*)(img + tid * ST_T + 256) = (v4u){Z | 0x3F80u, Z, Z, Z}; *(LAS v4u*)(img + tid * ST_T + 272) = (v4u){Z, Z, Z, Z}; }
}

__device__ __forceinline__ void ml_phase1(unsigned char* ws, cgf32* cw, cgf32* cb, LAS unsigned char* lds, int G, int bx, int tid_in, int wave, int lane_in) {
    int tid = tid_in, lane = lane_in;
    LAS unsigned char* KIMG = lds; LAS unsigned char* VIMG = lds + 128 * ST_T;
    LAS float* lf = (LAS float*)(lds + 2 * 128 * ST_T); LAS float* ig = lf + 128; LAS float* bc = ig + 128; LAS float* wa = bc + 128;
    cgf32* GT = (cgf32*)(ws + WS_GT); cgbf* QKM = (cgbf*)(ws + WS_QKM); cgbf* VM = (cgbf*)(ws + WS_VM);
    gf32* CC = (gf32*)(ws + WS_CC); gf32* NC = (gf32*)(ws + WS_NC); gf32* SCL = (gf32*)(ws + WS_SC);
    for (int unit = bx; unit < ML_UNITS; unit += G) {
        lane = my_lane_volatile(); tid = (wave << 6) | lane;
        const int g = lane >> 4, q = (lane >> 2) & 3, p = lane & 3;
        const unsigned Z = opaque0();
        const int c = unit & 63, h = (unit >> 6) & 3, b = unit >> 8, tok0 = b * S + c * 128;
        if (tid < 128) {
            float bt, ct, pm, bl, cmax; ml_gates_reg(GT, tok0, h, wave, lane, bt, ct, pm, bl, cmax);
            const float am = bl + cmax;
            wa[tid] = __expf(bl + ct - am);
            if (tid == 0) { SCL[unit * 4 + 0] = bl; SCL[unit * 4 + 1] = am; }
        }
        __syncthreads();
        ml_conv_tile(QKM, cw, cb, tok0, c, 512 + h * 128, KIMG, ST_T, __builtin_bit_cast(float, Z | 0x3db504f3u)  , wa, tid, Z);
        ml_v_tile(VM, tok0, h, VIMG, tid, Z);
        __syncthreads();
        bf16x8 af[4];
#pragma unroll
        for (int ks = 0; ks < 4; ++ks) { const LAS unsigned char* a = KIMG + (32 * ks + 8 * g + q) * ST_T + 32 * wave + 8 * p; af[ks] = cat8(tr16(a), tr16(a + 4 * ST_T)); }
        bf16x8 ones;
#pragma unroll
        for (int e = 0; e < 8; ++e) ones[e] = (short)0x3F80;
        pg8::f32x4 accn = {0.f, 0.f, 0.f, 0.f};
#pragma unroll
        for (int ks = 0; ks < 4; ++ks) accn = mfma16(af[ks], ones, accn);
        gf32* ccu = CC + (size_t)unit * 16384 + (size_t)(16 * wave + 4 * g) * 128 + (lane & 15);
#pragma unroll
        for (int nt = 0; nt < 8; ++nt) {
            pg8::f32x4 acc = {0.f, 0.f, 0.f, 0.f};
#pragma unroll
            for (int ks = 0; ks < 4; ++ks) { const LAS unsigned char* a = VIMG + (32 * ks + 8 * g + q) * ST_T + 32 * nt + 8 * p; const bf16x8 bfr = cat8(tr16(a), tr16(a + 4 * ST_T));
                acc = mfma16(af[ks], bfr, acc); }
#pragma unroll
            for (int r = 0; r < 4; ++r) ccu[r * 128 + 16 * nt] = acc[r];
        }
        if ((lane & 15) == 0) {
#pragma unroll
            for (int r = 0; r < 4; ++r) NC[unit * 128 + 16 * wave + 4 * g + r] = accn[r];
        }
        __syncthreads();
    }
}
__device__ __forceinline__ void ml_phase2(unsigned char* ws, int G, int bx, int tid) {
    cgf32* CC = (cgf32*)(ws + WS_CC); cgf32* NC = (cgf32*)(ws + WS_NC); gf32* SCL = (gf32*)(ws + WS_SC);
    GAS unsigned* CP = (GAS unsigned*)(ws + WS_CP); gf32* NP = (gf32*)(ws + WS_NP);
    const int gt = bx * NTHR + tid, GT_ = G * NTHR;
    for (int idx = gt; idx < 16 * 8192; idx += GT_) {
        const int pr = idx >> 13, e2 = idx & 8191;
        float m = 0.f, c0 = 0.f, c1 = 0.f;
        for (int cg = 0; cg < 64; cg += 16) {
            float bl[16], am[16]; f32x2_t cc[16];
#pragma unroll
            for (int k = 0; k < 16; ++k) { const int unit = pr * 64 + cg + k; bl[k] = SCL[unit * 4 + 0]; am[k] = SCL[unit * 4 + 1]; cc[k] = *(const GAS f32x2_t*)(CC + (size_t)unit * 16384 + 2 * e2); }
            asm volatile("" ::: "memory");
#pragma unroll
            for (int k = 0; k < 16; ++k) { const int unit = pr * 64 + cg + k;
                CP[(size_t)unit * 8192 + e2] = pk2(c0, c1);
                if (e2 == 0) SCL[unit * 4 + 2] = m;
                const float mn = fmaxf(bl[k] + m, am[k]), so = __expf(bl[k] + m - mn), sn = __expf(am[k] - mn);
                c0 = so * c0 + sn * cc[k].x; c1 = so * c1 + sn * cc[k].y; m = mn; }
            asm volatile("" ::: "memory");
        }
    }
    for (int idx = gt; idx < 16 * 128; idx += GT_) {
        const int pr = idx >> 7, d = idx & 127;
        float m = 0.f, n = 0.f;
        for (int cg = 0; cg < 64; cg += 16) {
            float bl[16], am[16], nc[16];
#pragma unroll
            for (int k = 0; k < 16; ++k) { const int unit = pr * 64 + cg + k; bl[k] = SCL[unit * 4 + 0]; am[k] = SCL[unit * 4 + 1]; nc[k] = NC[unit * 128 + d]; }
            asm volatile("" ::: "memory");
#pragma unroll
            for (int k = 0; k < 16; ++k) { const int unit = pr * 64 + cg + k;
                NP[unit * 128 + d] = n;
                const float mn = fmaxf(bl[k] + m, am[k]), so = __expf(bl[k] + m - mn), sn = __expf(am[k] - mn);
                n = so * n + sn * nc[k]; m = mn; }
            asm volatile("" ::: "memory");
        }
    }
}
__device__ __forceinline__ void ml_phase3(unsigned char* ws, cgf32* cw, cgf32* cb, cgf32* mnorm, LAS unsigned char* lds, int G, int bx, int tid_in, int wave, int lane_in) {
    int tid = tid_in, lane = lane_in;
    LAS unsigned char* QIMG = lds; LAS unsigned char* KIMG = lds + 128 * ST_R; LAS unsigned char* VIMG = lds + 2 * 128 * ST_R; LAS unsigned char* CIMG = lds;
    LAS float* lf = (LAS float*)(lds + 2 * 128 * ST_R + 128 * ST_T); LAS float* ig = lf + 128; LAS float* bc = ig + 128;
    LAS float* rowt = bc + 128; LAS float* colt = rowt + 128; LAS float* wint = colt + 128; LAS float* flo = wint + 128;
    cgf32* GT = (cgf32*)(ws + WS_GT); cgbf* QKM = (cgbf*)(ws + WS_QKM); cgbf* VM = (cgbf*)(ws + WS_VM); cgbf* OM = (cgbf*)(ws + WS_OM);
    cgf32* SCL = (cgf32*)(ws + WS_SC); cgf32* NP = (cgf32*)(ws + WS_NP); cgbf* CP = (cgbf*)(ws + WS_CP); gbf* MIX = (gbf*)(ws + WS_MIX);
    for (int unit = bx; unit < ML_UNITS; unit += G) {
        lane = my_lane_volatile(); tid = (wave << 6) | lane;
        const int g = lane >> 4, q = (lane >> 2) & 3, p = lane & 3, l15 = lane & 15;
        const unsigned Z = opaque0();
        const int c = unit & 63, h = (unit >> 6) & 3, b = unit >> 8, tok0 = b * S + c * 128;
        v4u cpr[4];
#pragma unroll
        for (int i = 0; i < 4; ++i) cpr[i] = *(cgv4u*)(CP + (size_t)unit * 16384 + (size_t)(tid + 512 * i) * 8);
        if (tid < 128) {
            float bt, ct, pm, bl, cmax; ml_gates_reg(GT, tok0, h, wave, lane, bt, ct, pm, bl, cmax);
            const float mp = SCL[unit * 4 + 2], gt = bt + mp, mt = fmaxf(gt, bt + pm);
            rowt[tid] = bt - mt; colt[tid] = ct; wint[tid] = __expf(gt - mt); flo[tid] = __expf(-mt);
        }
        ml_conv_tile(QKM, cw, cb, tok0, c, h * 128, QIMG, ST_R, 1.0f, nullptr, tid, Z);
        ml_conv_tile(QKM, cw, cb, tok0, c, 512 + h * 128, KIMG, ST_R, __builtin_bit_cast(float, Z | 0x3db504f3u), nullptr, tid, Z);
        ml_v_tile(VM, tok0, h, VIMG, tid, Z);
        __syncthreads();
        bf16x8 qf[4];
#pragma unroll
        for (int ks = 0; ks < 4; ++ks) qf[ks] = *(const LAS bf16x8*)(QIMG + (16 * wave + l15) * ST_R + 64 * ks + 16 * g);
        const int tq = 16 * wave + l15; const float rt = rowt[tq], wi = wint[tq];
        float pr[8][4];
#pragma unroll
        for (int st = 0; st < 8; ++st) {
            {
                pg8::f32x4 acc = {0.f, 0.f, 0.f, 0.f};
#pragma unroll
                for (int ks = 0; ks < 4; ++ks) { const bf16x8 kf = *(const LAS bf16x8*)(KIMG + (16 * st + l15) * ST_R + 64 * ks + 16 * g); acc = mfma16(kf, qf[ks], acc); }
                const pg8::f32x4 ct = *(const LAS pg8::f32x4*)(colt + 16 * st + 4 * g);
#pragma unroll
                for (int r = 0; r < 4; ++r) { const int s = 16 * st + 4 * g + r; const float wgt = __expf(rt + ct[r]); pr[st][r] = (s <= tq) ? acc[r] * wgt : 0.f; }
            }
        }
        __syncthreads();
#pragma unroll
        for (int i = 0; i < 4; ++i) { const int ch = tid + 512 * i, d = ch >> 4, cg = ch & 15; *(LAS v4u*)(CIMG + d * ST_T + 16 * cg) = cpr[i]; }
        if (tid < 128) { *(LAS v4u*)(CIMG + tid * ST_T + 256) = (v4u){f2bf(NP[unit * 128 + tid]), Z, Z, Z}; *(LAS v4u*)(CIMG + tid * ST_T + 272) = (v4u){Z, Z, Z, Z}; }
        __syncthreads();
        pg8::f32x4 acc2[9];
#pragma unroll
        for (int nt = 0; nt < 9; ++nt) acc2[nt] = (pg8::f32x4){0.f, 0.f, 0.f, 0.f};
#pragma unroll
        for (int ks = 0; ks < 4; ++ks) {
            v4u a3w;
#pragma unroll
            for (int e = 0; e < 4; ++e) a3w[e] = pk2(bf2f((unsigned short)qf[ks][2 * e]) * wi, bf2f((unsigned short)qf[ks][2 * e + 1]) * wi);
            const bf16x8 a3 = __builtin_bit_cast(bf16x8, a3w);
#pragma unroll
            for (int nt = 0; nt < 9; ++nt) { const LAS unsigned char* a = CIMG + (32 * ks + 8 * g + q) * ST_T + 32 * nt + 8 * p; acc2[nt] = mfma16(a3, cat8(tr16(a), tr16(a + 4 * ST_T)), acc2[nt]); }
        }
#pragma unroll
        for (int kk = 0; kk < 4; ++kk) {
            {
                v4u a2w; a2w[0] = pk2(pr[2 * kk][0], pr[2 * kk][1]); a2w[1] = pk2(pr[2 * kk][2], pr[2 * kk][3]); a2w[2] = pk2(pr[2 * kk + 1][0], pr[2 * kk + 1][1]); a2w[3] = pk2(pr[2 * kk + 1][2], pr[2 * kk + 1][3]);
                const bf16x8 a2 = __builtin_bit_cast(bf16x8, a2w);
#pragma unroll
                for (int nt = 0; nt < 9; ++nt) { const LAS unsigned char* a = VIMG + (32 * kk + 4 * g + q) * ST_T + 32 * nt + 8 * p; acc2[nt] = mfma16(a2, cat8(tr16(a), tr16(a + 16 * ST_T)), acc2[nt]); }
            }
        }
        const pg8::f32x4 fl = *(const LAS pg8::f32x4*)(flo + 16 * wave + 4 * g);
        float inv[4], ssq[4];
#pragma unroll
        for (int r = 0; r < 4; ++r) { const float den = shfrom(acc2[8][r], lane & 48); inv[r] = 1.0f / fmaxf(fabsf(den), fl[r]); ssq[r] = 0.f; }
#pragma unroll
        for (int nt = 0; nt < 8; ++nt)
#pragma unroll
            for (int r = 0; r < 4; ++r) { acc2[nt][r] *= inv[r]; ssq[r] += acc2[nt][r] * acc2[nt][r]; }
#pragma unroll
        for (int r = 0; r < 4; ++r) { float s = ssq[r]; s += shx(s, 1, lane); s += shx(s, 2, lane); s += shx(s, 4, lane); s += shx(s, 8, lane); ssq[r] = rsqrtf(s * (1.0f / 128.0f) + EPS); }
        unsigned char om8[8][4]; float gnv[8];
#pragma unroll
        for (int nt = 0; nt < 8; ++nt) {
            const int e = 16 * nt + l15; gnv[nt] = mnorm[h * 128 + e];
#pragma unroll
            for (int r = 0; r < 4; ++r) om8[nt][r] = ((const GAS unsigned char*)OM)[(size_t)(tok0 + 16 * wave + 4 * g + r) * 512 + h * 128 + e];
        }
        asm volatile("" ::: "memory");
#pragma unroll
        for (int nt = 0; nt < 8; ++nt) {
            const int e = 16 * nt + l15;
#pragma unroll
            for (int r = 0; r < 4; ++r) {
                const size_t tok = (size_t)(tok0 + 16 * wave + 4 * g + r);
                const float o = __builtin_amdgcn_cvt_f32_fp8((int)om8[nt][r], 0);
                { const float val = acc2[nt][r] * ssq[r] * gnv[nt] * fast_sigmoid(o); MIX[tok * 1024 + 512 + h * 128 + e] = (bf16_t)pk2(val, val); }
            }
        }
        __syncthreads();
    }
}

#ifndef REP_M1
#define REP_M1 1
#endif
#ifndef REP_M2
#define REP_M2 1
#endif
#ifndef REP_M3
#define REP_M3 1
#endif
#ifndef REP_DSA
#define REP_DSA 1
#endif
#define LAUNDER_TID int tl = MYTID(); asm volatile("" : "+v"(tl)); const int ll = tl & 63, wl_ = __builtin_amdgcn_readfirstlane(tl >> 6);
#define MIXER_M1 { if (!(P.flags & 2)) { for (int rep = 0; rep < REP_M1; ++rep) { LAUNDER_TID ml_phase1(ws, (cgf32*)(P.in[I_CW] + (size_t)l * 4096), (cgf32*)(P.in[I_CB] + l * 1024), lds, G, bx, tl, wl_, ll); } } }
#define MIXER_M2_DSA { if (!(P.flags & 1)) { for (int rep = 0; rep < REP_DSA; ++rep) { LAUNDER_TID dsa_phase(ws, (unsigned char*)X, lds, G, bx, tl, wl_, ll); } } if (!(P.flags & 2)) { for (int rep = 0; rep < REP_M2; ++rep) { LAUNDER_TID ml_phase2(ws, G, bx, tl); } } }
#define MIXER_M3 { if (!(P.flags & 2)) { for (int rep = 0; rep < REP_M3; ++rep) { LAUNDER_TID ml_phase3(ws, (cgf32*)(P.in[I_CW] + (size_t)l * 4096), (cgf32*)(P.in[I_CB] + l * 1024), (cgf32*)(P.in[I_MNORM] + l * 512), lds, G, bx, tl, wl_, ll); } } }
typedef float f32x16 __attribute__((ext_vector_type(16)));
__device__ __forceinline__ f32x16 mfma32(bf16x8 a, bf16x8 b, f32x16 c) {
    c = __builtin_amdgcn_mfma_f32_32x32x16_bf16(a, b, c, 0, 0, 0);
    asm volatile("s_nop 3" : "+v"(c) : "v"(a), "v"(b));
    return c;
}
#ifndef REP_IDX
#define REP_IDX 1
#endif
#ifndef REP_ATT
#define REP_ATT 1
#endif
__device__ __forceinline__ f32x16 mfma32_raw(bf16x8 a, bf16x8 b, f32x16 c) { return __builtin_amdgcn_mfma_f32_32x32x16_bf16(a, b, c, 0, 0, 0); }
__device__ __forceinline__ pg8::f32x4 mfma16_f8(long a, long b, pg8::f32x4 c) {
    c = __builtin_amdgcn_mfma_f32_16x16x32_fp8_fp8(a, b, c, 0, 0, 0);
    asm volatile("s_nop 3" : "+v"(c) : "v"(a), "v"(b));
    return c;
}
constexpr int DSA_QB = 32;
constexpr int DSA_SEL = 0, DSA_SMALL = 16384, DSA_HIST = 17408, DSA_VBUF = 17408, DSA_VROW = 144, DSA_TMOFF = 256 * 33, DSA_OBUF = 98304;
__device__ __forceinline__ float relu1(float x) { return __builtin_amdgcn_fmed3f(x, 0.f, 3.0e38f); }
__device__ __forceinline__ unsigned lds_add(LAS unsigned* p, unsigned v) { return __hip_atomic_fetch_add(p, v, __ATOMIC_RELAXED, __HIP_MEMORY_SCOPE_WORKGROUP); }
__device__ __forceinline__ unsigned q20key(float sc) {
    const unsigned u = __builtin_bit_cast(unsigned, sc);
    int v = (int)((u & 0x7fffffffu) >> 9) - (107 << 14);
    v = v < 0 ? 0 : (v > 0x7ffff ? 0x7ffff : v);
    const unsigned s = (unsigned)((int)u >> 31);
    return (unsigned)v ^ (0x80000u ^ (s & 0xfffffu));
}
__device__ __forceinline__ void hist_select(const LAS unsigned* hrow, unsigned need, int lane, unsigned& bin_out, unsigned& above_out, int nl = 64) {
    const pg8::u32x4 a = *(const LAS pg8::u32x4*)(hrow + 8 * lane), b = *(const LAS pg8::u32x4*)(hrow + 8 * lane + 4);
    unsigned c[8] = {a[0], a[1], a[2], a[3], b[0], b[1], b[2], b[3]};
    unsigned tot = 0;
#pragma unroll
    for (int j = 0; j < 8; ++j) tot += c[j];
    if (lane >= nl) tot = 0;
    unsigned incl = tot;
#pragma unroll
    for (int d = 1; d < 64; d <<= 1) { const unsigned y = shfrom(incl, lane + d); incl += (lane + d < 64) ? y : 0u; }
    const unsigned excl = incl - tot;
    unsigned bin = 0, above = 0; const bool mine = excl < need && need <= incl;
    if (mine) {
        unsigned acc = excl; bool done = false;
#pragma unroll
        for (int j = 7; j >= 0; --j) { if (!done && acc + c[j] >= need) { bin = 8 * lane + j; above = acc; done = true; } if (!done) acc += c[j]; }
    }
    const unsigned long long bal = __ballot(mine);
    const int src = bal ? (int)__builtin_ctzll(bal) : 0;
    bin_out = shfrom(bin, src); above_out = shfrom(above, src);
}
__device__ __forceinline__ unsigned lin_key(float sc, float cscale) { return (unsigned)__builtin_amdgcn_fmed3f(fmaf(sc, cscale, 32768.5f), 0.f, 65535.f); }
template <int PASS>
__device__ __forceinline__ void dsa_pass(LAS unsigned char* lds, cgbf* KI, cgbf* QI, GAS v4u* keys, size_t tokb, int qb, int wave, int lane_in, pg8::f32x4 w4, float cscale_unused, unsigned ref) {
    float cscale = cscale_unused;
    const int lane = my_lane_volatile(); (void)lane_in;
    LAS unsigned* HIST = (LAS unsigned*)(lds + DSA_HIST); LAS unsigned* BMP = (LAS unsigned*)(lds + DSA_HIST);
    LAS unsigned* SM = (LAS unsigned*)(lds + DSA_SMALL);
    const int rr = lane & 31, hh = lane >> 5;
    LAS unsigned* hrow = HIST + rr * 512;
    if (PASS == 0) {
        bf16x8 qf[4][4];
#pragma unroll
        for (int h = 0; h < 4; ++h)
#pragma unroll
            for (int s = 0; s < 4; ++s) qf[h][s] = __builtin_bit_cast(bf16x8, *(cgv4u*)(QI + (tokb + 32 * qb + rr) * 256 + h * 64 + 16 * s + 8 * hh));
        bf16x8 kf[4];
        int kt = wave;
#pragma unroll
        for (int s = 0; s < 4; ++s) kf[s] = __builtin_bit_cast(bf16x8, *(cgv4u*)(KI + (tokb + 32 * kt + rr) * 64 + 16 * s + 8 * hh));
        { float rng = 0.f;
#pragma unroll
          for (int h = 0; h < 4; ++h) { float ss = 0.f;
#pragma unroll
              for (int s = 0; s < 4; ++s)
#pragma unroll
                  for (int e = 0; e < 8; ++e) { const float x = bf2f((unsigned short)qf[h][s][e]); ss += x * x; }
              ss += shx(ss, 32, lane);
              rng += fabsf(w4[h]) * sqrtf(ss); }
          cscale = 32768.0f / fmaxf(12.0f * rng, 1e-20f); }
        for (; kt <= qb; kt += 8) {
            bf16x8 kn[4];
            const int ktn = (kt + 8 <= qb) ? kt + 8 : kt;
#pragma unroll
            for (int s = 0; s < 4; ++s) kn[s] = __builtin_bit_cast(bf16x8, *(cgv4u*)(KI + (tokb + 32 * ktn + rr) * 64 + 16 * s + 8 * hh));
            f32x16 sc;
#pragma unroll
            for (int i = 0; i < 16; ++i) sc[i] = 0.f;
#pragma unroll
            for (int hp = 0; hp < 2; ++hp) {
                f32x16 a0, a1;
#pragma unroll
                for (int i = 0; i < 16; ++i) { a0[i] = 0.f; a1[i] = 0.f; }
#pragma unroll
                for (int s = 0; s < 4; ++s) { a0 = mfma32_raw(kf[s], qf[2 * hp][s], a0); a1 = mfma32_raw(kf[s], qf[2 * hp + 1][s], a1); }
#pragma unroll
                for (int i = 0; i < 16; ++i) sc[i] = fmaf(w4[2 * hp + 1], relu1(a1[i]), fmaf(w4[2 * hp], relu1(a0[i]), sc[i]));
            }
            asm volatile("s_nop 3" :: "v"(kf[0]), "v"(kf[1]), "v"(kf[2]), "v"(kf[3]));
            unsigned kw[8];
            if (kt != qb) {
#pragma unroll
                for (int i = 0; i < 16; ++i) { const unsigned k16 = lin_key(sc[i], cscale);
                    lds_add(hrow + (k16 >> 7), 1u);
                    if (i & 1) kw[i >> 1] |= k16 << 16; else kw[i >> 1] = k16; }
            } else {
#pragma unroll
                for (int i = 0; i < 16; ++i) { const bool v = ((i & 3) + 8 * (i >> 2) + 4 * hh) <= rr; const unsigned k16 = v ? lin_key(sc[i], cscale) : 0u;
                    lds_add(hrow + (k16 >> 7), v ? 1u : 0u);
                    if (i & 1) kw[i >> 1] |= k16 << 16; else kw[i >> 1] = k16; }
            }
            keys[(size_t)(kt * 64 + lane) * 2] = (v4u){kw[0], kw[1], kw[2], kw[3]};
            keys[(size_t)(kt * 64 + lane) * 2 + 1] = (v4u){kw[4], kw[5], kw[6], kw[7]};
#pragma unroll
            for (int s = 0; s < 4; ++s) kf[s] = kn[s];
        }
    } else {
        for (int kt = wave; kt <= qb; kt += 8) {
            const v4u ka = keys[(size_t)(kt * 64 + lane) * 2], kb = keys[(size_t)(kt * 64 + lane) * 2 + 1];
            unsigned kw[8] = {ka[0], ka[1], ka[2], ka[3], kb[0], kb[1], kb[2], kb[3]};
            if (PASS == 1) {
#pragma unroll
                for (int i = 0; i < 16; ++i) { const unsigned k16 = (i & 1) ? (kw[i >> 1] >> 16) : (kw[i >> 1] & 0xffffu);
                    lds_add(hrow + (k16 & 127u), (k16 >> 7) == ref ? 1u : 0u); }
            } else {
                unsigned mg = 0u, me = 0u;
#pragma unroll
                for (int i = 0; i < 16; ++i) { const unsigned k16 = (i & 1) ? (kw[i >> 1] >> 16) : (kw[i >> 1] & 0xffffu); const unsigned bit = 1u << ((i & 3) + 8 * (i >> 2));
                    mg |= k16 > ref ? bit : 0u; me |= k16 == ref ? bit : 0u; }
                mg <<= 4 * hh; me <<= 4 * hh;
                mg |= shx(mg, 32, lane); me |= shx(me, 32, lane);
                if (hh == 0) { BMP[kt * 33 + rr] = mg; BMP[DSA_TMOFF + kt * 33 + rr] = me; }
            }
        }
    }
}
__device__ __forceinline__ void dsa_unit(unsigned char* ws, GAS v4u* keys, LAS unsigned char* lds, int b, int qb, int tid_in, int wave, int lane_in) {
    int lane = my_lane_volatile(), tid = (wave << 6) | lane; (void)lane_in; (void)tid_in;
    cgbf* QI = (cgbf*)(ws + WS_QI); cgbf* KI = (cgbf*)(ws + WS_KI); cgf32* GT = (cgf32*)(ws + WS_GT);
    cgbf* Qa = (cgbf*)(ws + WS_Q); cgbf* KV = (cgbf*)(ws + WS_KV); gbf* MIX = (gbf*)(ws + WS_MIX);
    LAS unsigned* HIST = (LAS unsigned*)(lds + DSA_HIST); LAS unsigned short* SEL = (LAS unsigned short*)(lds + DSA_SEL);
    LAS unsigned* SM = (LAS unsigned*)(lds + DSA_SMALL);
    const int rr = lane & 31, hh = lane >> 5;
    const unsigned Z = opaque0();
    const int t0 = DSA_QB * qb; const size_t tokb = (size_t)b * S;
    for (int rep_i = 0; rep_i < REP_IDX; ++rep_i) {
    if (qb >= 8) {
        const pg8::f32x4 w4 = *(cgf32x4*)(GT + (tokb + t0 + rr) * 16);
        const float cscale = 0.f;
        unsigned my_bstar = 0, my_thr = 0;
        for (int pass = 0; pass < 3; ++pass) {
            if (pass < 2) {
#pragma unroll
                for (int i = 0; i < 8; ++i) *(LAS pg8::u32x4*)(lds + DSA_HIST + (tid + 512 * i) * 16) = (pg8::u32x4){Z, Z, Z, Z};
            }
            __syncthreads();
            if (pass == 0) dsa_pass<0>(lds, KI, QI, keys, tokb, qb, wave, lane, w4, cscale, 0u);
            else if (pass == 1) dsa_pass<1>(lds, KI, QI, keys, tokb, qb, wave, lane, w4, cscale, my_bstar);
            else dsa_pass<2>(lds, KI, QI, keys, tokb, qb, wave, lane, w4, cscale, my_thr);
            __syncthreads();
            if (pass == 0) {
#pragma unroll
                for (int j = 0; j < 4; ++j) { const int row = 4 * wave + j; unsigned bin, above; hist_select(HIST + row * 512, 256u, lane, bin, above); if (lane == 0) { SM[row] = bin; SM[32 + row] = above; } }
            } else if (pass == 1) {
#pragma unroll
                for (int j = 0; j < 4; ++j) { const int row = 4 * wave + j; const unsigned ab1 = SM[32 + row]; unsigned sb, above; hist_select(HIST + row * 512, 256u - ab1, lane, sb, above, 16);
                    if (lane == 0) { SM[64 + row] = (SM[row] << 7) | sb; SM[96 + row] = 256u - ab1 - above; } }
            } else {
                const LAS unsigned* BMP = (const LAS unsigned*)(lds + DSA_HIST);
                for (int j = 0; j < 4; ++j) {
                    const int row = 4 * wave + j;
                    const unsigned need = SM[96 + row];
                    unsigned bw[4], tw[4];
#pragma unroll
                    for (int e = 0; e < 4; ++e) { const int wi = lane + 64 * e; const bool ok = wi <= qb; bw[e] = ok ? BMP[wi * 33 + row] : 0u; tw[e] = ok ? BMP[DSA_TMOFF + wi * 33 + row] : 0u; }
                    unsigned m = (unsigned)(__builtin_popcount(tw[0]) + __builtin_popcount(tw[1]) + __builtin_popcount(tw[2]) + __builtin_popcount(tw[3]));
#pragma unroll
                    for (int o = 1; o < 64; o <<= 1) m += shx(m, o, lane);
                    if (m > need) {
                        unsigned lo = 0, hi = 8191;
                        while (lo < hi) { const unsigned mid = (lo + hi) >> 1; unsigned c = 0;
#pragma unroll
                            for (int e = 0; e < 4; ++e) { const int nb = (int)mid + 1 - 32 * (lane + 64 * e); const unsigned km = nb >= 32 ? 0xffffffffu : (nb <= 0 ? 0u : ((1u << nb) - 1u)); c += (unsigned)__builtin_popcount(tw[e] & km); }
#pragma unroll
                            for (int o = 1; o < 64; o <<= 1) c += shx(c, o, lane);
                            if (c >= need) hi = mid; else lo = mid + 1; }
#pragma unroll
                        for (int e = 0; e < 4; ++e) { const int nb = (int)lo + 1 - 32 * (lane + 64 * e); const unsigned km = nb >= 32 ? 0xffffffffu : (nb <= 0 ? 0u : ((1u << nb) - 1u)); tw[e] &= km; }
                    }
                    unsigned cnt = 0;
#pragma unroll
                    for (int e = 0; e < 4; ++e) { bw[e] |= tw[e]; cnt += (unsigned)__builtin_popcount(bw[e]); }
                    unsigned incl = cnt;
#pragma unroll
                    for (int d = 1; d < 64; d <<= 1) { const unsigned y = shfrom(incl, lane - d); incl += (lane >= d) ? y : 0u; }
                    unsigned pos = incl - cnt;
#pragma unroll
                    for (int e = 0; e < 4; ++e) { unsigned w = bw[e]; const unsigned kb = 32u * (unsigned)(lane + 64 * e);
                        while (w) { const unsigned bit = (unsigned)__builtin_ctz(w); if (pos < 256u) SEL[row * 256 + pos] = (unsigned short)(kb + bit); ++pos; w &= w - 1u; } }
                }
            }
            __syncthreads();
            if (pass == 0) my_bstar = SM[rr]; else if (pass == 1) my_thr = SM[64 + rr];
        }
    } else {
        for (int i = tid; i < DSA_QB * 256; i += NTHR) SEL[i] = (unsigned short)(i & 255);
        __syncthreads();
    }
    }
    lane = my_lane_volatile();
    const int c = lane & 15, kg = lane >> 4, q4 = (lane >> 2) & 3, p4 = lane & 3;
    LAS unsigned char* vb = lds + DSA_VBUF + wave * (2 * 32 * DSA_VROW);
    const GAS unsigned char* KVb = (const GAS unsigned char*)KV + tokb * 128;
    for (int rep_a = 0; rep_a < REP_ATT; ++rep_a)
    for (int qq = 0; qq < 4; ++qq) {
        const int r = 4 * wave + qq, t = t0 + r; const int cnt = t + 1 < 256 ? t + 1 : 256;
        const LAS unsigned short* sel = SEL + r * 256;
        long qa[2];
#pragma unroll
        for (int s = 0; s < 2; ++s) { const pg8::u32x2 x = *(const GAS pg8::u32x2*)((const GAS unsigned char*)Qa + (tokb + t) * 512 + (c & 7) * 64 + 16 * kg + 8 * s);
            qa[s] = c >= 8 ? (long)(unsigned long long)Z : (long)(((unsigned long long)x[1] << 32) | x[0]); }
        float lg[8][2][4];
        {
            v4u kfr[8][2];
#pragma unroll
            for (int ch = 0; ch < 8; ++ch)
#pragma unroll
                for (int ab = 0; ab < 2; ++ab) { const int slot = 32 * ch + 16 * ab + c; const unsigned idx = slot < cnt ? (unsigned)sel[slot] : 0u;
                    kfr[ch][ab] = *(cgv4u*)(KVb + (idx * 128u + 16u * kg)); }
#pragma unroll
            for (int ch = 0; ch < 8; ++ch)
#pragma unroll
                for (int ab = 0; ab < 2; ++ab) { pg8::f32x4 acc = {0.f, 0.f, 0.f, 0.f};
                    acc = mfma16_f8((long)(((unsigned long long)kfr[ch][ab][1] << 32) | kfr[ch][ab][0]), qa[0], acc);
                    acc = mfma16_f8((long)(((unsigned long long)kfr[ch][ab][3] << 32) | kfr[ch][ab][2]), qa[1], acc);
#pragma unroll
                    for (int e = 0; e < 4; ++e) lg[ch][ab][e] = acc[e]; }
        }
        if (cnt < 256) {
#pragma unroll
            for (int ch = 0; ch < 8; ++ch)
#pragma unroll
                for (int ab = 0; ab < 2; ++ab)
#pragma unroll
                    for (int e = 0; e < 4; ++e) if (32 * ch + 16 * ab + 4 * kg + e >= cnt) lg[ch][ab][e] = -INFINITY;
        }
        v4u vr[4][2][2];
#pragma unroll
        for (int bt = 0; bt < 4; ++bt)
#pragma unroll
            for (int cc = 0; cc < 2; ++cc)
#pragma unroll
                for (int i = 0; i < 2; ++i) { const int j = (lane >> 2) + 16 * i, slot = 32 * (2 * bt + cc) + j; const unsigned idx = slot < cnt ? (unsigned)sel[slot] : 0u;
                    vr[bt][cc][i] = *(cgv4u*)(KVb + (idx * 128u + 64u + 16u * (lane & 3))); }
        float mx = -INFINITY;
#pragma unroll
        for (int ch = 0; ch < 8; ++ch)
#pragma unroll
            for (int ab = 0; ab < 2; ++ab)
#pragma unroll
                for (int e = 0; e < 4; ++e) mx = fmaxf(mx, lg[ch][ab][e]);
        mx = fmaxf(mx, shx(mx, 16, lane)); mx = fmaxf(mx, shx(mx, 32, lane));
        const float C8 = 0.18033688011112042f, mxc = mx * C8;
        float sum = 0.f;
#pragma unroll
        for (int ch = 0; ch < 8; ++ch)
#pragma unroll
            for (int ab = 0; ab < 2; ++ab)
#pragma unroll
                for (int e = 0; e < 4; ++e) { const float pe = __builtin_amdgcn_exp2f(fmaf(lg[ch][ab][e], C8, -mxc)); lg[ch][ab][e] = pe; sum += pe; }
        sum += shx(sum, 16, lane); sum += shx(sum, 32, lane);
        const float isum = 1.0f / sum;
        pg8::f32x4 o[4];
#pragma unroll
        for (int nt = 0; nt < 4; ++nt) o[nt] = (pg8::f32x4){0.f, 0.f, 0.f, 0.f};
#pragma unroll
        for (int bt = 0; bt < 4; ++bt) {
#pragma unroll
            for (int cc = 0; cc < 2; ++cc)
#pragma unroll
                for (int i = 0; i < 2; ++i) { const int j = (lane >> 2) + 16 * i; const v4u x = vr[bt][cc][i]; v4u w0, w1;
#pragma unroll
                    for (int e = 0; e < 4; ++e) { const pg8::f32x2 f0 = __builtin_amdgcn_cvt_pk_f32_fp8((int)x[e], false), f1 = __builtin_amdgcn_cvt_pk_f32_fp8((int)x[e], true);
                        const unsigned a = pk2(f0[0], f0[1]), b = pk2(f1[0], f1[1]);
                        if (e < 2) { w0[2 * e] = a; w0[2 * e + 1] = b; } else { w1[2 * (e - 2)] = a; w1[2 * (e - 2) + 1] = b; } }
                    LAS unsigned char* d = vb + (32 * cc + j) * DSA_VROW + 32 * (lane & 3);
                    *(LAS v4u*)(d) = w0; *(LAS v4u*)(d + 16) = w1; }
#pragma unroll
            for (int cc = 0; cc < 2; ++cc) { const int ch = 2 * bt + cc;
                pg8::u32x4 a2w;
                a2w[0] = pg8::cvt_pk_bf16(lg[ch][0][0] * isum, lg[ch][0][1] * isum); a2w[1] = pg8::cvt_pk_bf16(lg[ch][0][2] * isum, lg[ch][0][3] * isum);
                a2w[2] = pg8::cvt_pk_bf16(lg[ch][1][0] * isum, lg[ch][1][1] * isum); a2w[3] = pg8::cvt_pk_bf16(lg[ch][1][2] * isum, lg[ch][1][3] * isum);
                const bf16x8 a2 = __builtin_bit_cast(bf16x8, a2w);
#pragma unroll
                for (int nt = 0; nt < 4; ++nt) { const LAS unsigned char* a = vb + (32 * cc + 4 * kg + q4) * DSA_VROW + 32 * nt + 8 * p4; o[nt] = mfma16(a2, cat8(tr16(a), tr16(a + 16 * DSA_VROW)), o[nt]); }
            }
        }
        if (kg < 2) {
            LAS unsigned short* ob = (LAS unsigned short*)(lds + DSA_OBUF + wave * 4096 + qq * 1024);
#pragma unroll
            for (int nt = 0; nt < 4; ++nt)
#pragma unroll
                for (int e = 0; e < 4; ++e) ob[(4 * kg + e) * 64 + 16 * nt + c] = (unsigned short)f2bf(o[nt][e]);
        }
    }
    LDS_WAIT();
#pragma unroll
    for (int qq = 0; qq < 4; ++qq) {
        const v4u x = *(const LAS v4u*)(lds + DSA_OBUF + wave * 4096 + qq * 1024 + lane * 16);
        *(GAS v4u*)(MIX + (tokb + t0 + 4 * wave + qq) * 1024 + lane * 8) = x;
    }
    __syncthreads();
}
__device__ __forceinline__ void dsa_phase(unsigned char* ws, unsigned char* keyscr, LAS unsigned char* lds, int G, int bx, int tid, int wave, int lane) {
    GAS v4u* keys = (GAS v4u*)(keyscr + (size_t)(bx & 255) * (MiB / 2));
#pragma unroll 1
    for (int u = bx; u < NB * 256; u += G) { const int i = (u >> 2) & 63, k = u >> 8; const int qb = (k == 0) ? 255 - i : (k == 1) ? 128 + i : (k == 2) ? 127 - i : i; dsa_unit(ws, keys, lds, u & 3, qb, tid, wave, lane); }
}
#ifndef REP_UP
#define REP_UP 1
#endif
#ifndef REP_INP
#define REP_INP 1
#endif
constexpr int PH_PER_LAYER = 9, NPHASE = 1 + DEPTH * PH_PER_LAYER;
__global__ void __launch_bounds__(NTHR, 2) mega_fwd(Params P) {
    extern __shared__ __attribute__((aligned(16))) unsigned char lds_raw[];
    LAS unsigned char* lds = (LAS unsigned char*)lds_raw;
    volatile LAS unsigned* MISC = (volatile LAS unsigned*)(lds + MISC_OFF);
    const int wave = __builtin_amdgcn_readfirstlane(threadIdx.x >> 6);
#define MYLANE() my_lane_volatile()
#define MYTID() ((wave << 6) | MYLANE())
    const int tid = MYTID(), lane = tid & 63;
    const int G = gridDim.x;
    gu32* ctl = (gu32*)(P.ws + WS_CTL);
    for (int u = tid; u < (LDS_BYTES - LDSCTL_OFF) / 4; u += NTHR) ((LAS unsigned*)(lds + LDSCTL_OFF))[u] = 0u;
    __syncthreads();
    XcdBarrier bar = xcd_barrier_post((unsigned*)(ctl + CW_BAR) + P.li * XCD_BAR_WORDS, MISC + 8, wave);
#if HYB
    const int lo = P.ph_lo, hi = P.ph_hi;
#endif
#if HYB
#define IN(k) (lo <= (k) && (k) < hi)
#define SEAM(k) do { if (IN(k) && IN((k) + 1)) xcd_barrier(bar); } while (0)
#else
#define IN(k) (true)
#define SEAM(k) do { xcd_barrier(bar); } while (0)
#endif

#ifndef REP_P0
#define REP_P0 1
#endif
    for (int rep0 = 0; rep0 < REP_P0; ++rep0)
    if (IN(0)) { const int bx0 = blockIdx.x; const int vcu = (G % 8 == 0) ? (bx0 % 8) * (G / 8) + bx0 / 8 : bx0; p0_prologue(P, lds, vcu, G, wave, lane); }
    SEAM(0);

    for (int l = 0; l < DEPTH; ++l) {
        const int pb = 1 + l * PH_PER_LAYER;
        for (int f = 0; f < 2; ++f) {
            int bx = (int)blockIdx.x; asm volatile("" : "+s"(bx));
            unsigned char* ws = P.ws; asm volatile("" : "+s"(ws));
            float* X = P.out; asm volatile("" : "+s"(X));
            bf16_t* XB = (bf16_t*)(ws + WS_XB); float* SS = (float*)(ws + WS_SS); bf16_t* ACT = (bf16_t*)(ws + WS_ACT);
            unsigned char* wl = ws + WS_W + (size_t)l * W_LAYER;
            if (f == 1) {
                for (int rep_n = 0; rep_n < REP_INP; ++rep_n)
                if (IN(pb + 2)) {
                    pg8::Gemm g{XB, (const bf16_t*)(wl + WO_IN), T, INP, D}; pg8::StaticOrder So; So.init(T, INP, G, bx);
                    pg8::EpiIn E{(pg8::cgf32*)SS, (pg8::cgf32*)(ws + WS_CS), (pg8::cgf32*)(P.in[I_QN] + l * 64), (pg8::cgf32*)(P.in[I_KN] + l * 64), (pg8::cgf32*)(P.in[I_GB] + l * 8),
                                 (pg8::gbf16*)(ws + WS_Q), (pg8::gbf16*)(ws + WS_KV), (pg8::gbf16*)(ws + WS_QI), (pg8::gbf16*)(ws + WS_KI), (pg8::gbf16*)(ws + WS_QKM), (pg8::gbf16*)(ws + WS_VM), (pg8::gbf16*)(ws + WS_OM), (pg8::gf32*)(ws + WS_GT)};
                    pg8::gemm_phase<pg8::EpiIn, pg8::StaticOrder, true, true>(lds, g, So, E, MYTID());
                }
                SEAM(pb + 2);
                if (IN(pb + 3)) { MIXER_M1 }
                SEAM(pb + 3);
                if (IN(pb + 4)) { MIXER_M2_DSA }
                SEAM(pb + 4);
                if (IN(pb + 5)) { MIXER_M3 }
                SEAM(pb + 5);
                if (IN(pb + 6)) {
                    pg8::Gemm g{(const bf16_t*)(ws + WS_MIX), (const bf16_t*)(wl + WO_OUT), T, D, D}; pg8::StaticOrder So; So.init(T, D, G, bx);
                    if (FP8UPLAST && l == DEPTH - 1) { pg8::EpiRes<false, true> E{(pg8::gf32*)X, (pg8::gbf16*)XB, (pg8::gf32*)SS, (PG8_GAS unsigned char*)(ws + WS_XB8), 1.0f};
                        pg8::gemm_phase<pg8::EpiRes<false, true>, pg8::StaticOrder, true, true>(lds, g, So, E, MYTID()); }
                    else { pg8::EpiRes<false> E{(pg8::gf32*)X, (pg8::gbf16*)XB, (pg8::gf32*)SS, (PG8_GAS unsigned char*)nullptr, 1.0f};
                        pg8::gemm_phase<pg8::EpiRes<false>, pg8::StaticOrder, true, true>(lds, g, So, E, MYTID()); }
                }
                SEAM(pb + 6);
            }
            const int pu = pb + (f ? 7 : 0);
            for (int rep_u = 0; rep_u < REP_UP; ++rep_u)
            if (IN(pu)) {
                pg8::StaticOrder So; So.init(T, 2 * DFF, G, bx);
                if (FP8UPLAST && l == DEPTH - 1 && f == 1) {
                    pg8::Gemm g{(const bf16_t*)(ws + WS_XB8), (const bf16_t*)(wl + WO_U2), T, 2 * DFF, D / 2};
                    pg8::EpiUp E{(PG8_GAS unsigned char*)ACT, (pg8::cgf32*)SS, 1.0f / pg8::WUP_SCALE};
                    pg8::gemm_phase<pg8::EpiUp, pg8::StaticOrder, true, true, true>(lds, g, So, E, MYTID());
                } else {
                    pg8::Gemm g{XB, (const bf16_t*)(wl + (f ? WO_U2 : WO_U1)), T, 2 * DFF, D};
                    pg8::EpiUp E{(PG8_GAS unsigned char*)ACT, (pg8::cgf32*)SS, 1.0f};
                    pg8::gemm_phase<pg8::EpiUp, pg8::StaticOrder, true, true>(lds, g, So, E, MYTID());
                }
            }
            SEAM(pu);
            if (IN(pu + 1)) {
                constexpr float a_dn = FP8DOWN ? 0.5f / (pg8::ACT_SCALE * pg8::WDN_SCALE) : 0.5f;
                pg8::Gemm g{ACT, (const bf16_t*)(wl + (f ? WO_D2 : WO_D1)), T, D, FP8DOWN ? DFF / 2 : DFF}; pg8::StaticOrder So; So.init(T, D, G, bx);
                if (l == DEPTH - 1 && f == 1) { pg8::EpiRes<true> E{(pg8::gf32*)X, (pg8::gbf16*)XB, (pg8::gf32*)SS, (PG8_GAS unsigned char*)nullptr, a_dn}; pg8::gemm_phase<pg8::EpiRes<true>, pg8::StaticOrder, true, true, FP8DOWN != 0>(lds, g, So, E, MYTID()); }
                else { pg8::EpiRes<false> E{(pg8::gf32*)X, (pg8::gbf16*)XB, (pg8::gf32*)SS, (PG8_GAS unsigned char*)nullptr, a_dn}; pg8::gemm_phase<pg8::EpiRes<false>, pg8::StaticOrder, true, true, FP8DOWN != 0>(lds, g, So, E, MYTID()); }
            }
            if (!(l == DEPTH - 1 && f == 1)) SEAM(pu + 1);
        }
    }
#undef IN
#undef SEAM
}
extern "C" void kernel_launch(void* const* d_in, const int* in_sizes, int n_in, void* d_out, int out_size, void* d_ws, size_t ws_size, hipStream_t stream) {
    static int grid = 0;
    if (grid == 0) {
        if (n_in != 18 || out_size != T * D || ws_size < WS_END) { fprintf(stderr, "kernel_launch: unexpected sizes (n_in %d out %d ws %zu)\n", n_in, out_size, ws_size); grid = -1; return; }
        int dev = 0, cus = 0, per_cu = 0;
        if (hipGetDevice(&dev) != hipSuccess || hipDeviceGetAttribute(&cus, hipDeviceAttributeMultiprocessorCount, dev) != hipSuccess) { grid = -1; return; }
        if (hipFuncSetAttribute((const void*)mega_fwd, hipFuncAttributeMaxDynamicSharedMemorySize, LDS_BYTES) != hipSuccess) { fprintf(stderr, "kernel_launch: hipFuncSetAttribute failed\n"); grid = -1; return; }
        if (hipOccupancyMaxActiveBlocksPerMultiprocessor(&per_cu, (const void*)mega_fwd, NTHR, LDS_BYTES) != hipSuccess || per_cu < 1)
            fprintf(stderr, "kernel_launch: note: occupancy query reports %d workgroups per CU\n", per_cu);
        (void)hipGetLastError();
        grid = cus > 256 ? 256 : cus;
    }
    if (grid < 0) return;
    if (hipMemsetAsync((char*)d_ws + WS_CTL, 0, CTL_ZERO_BYTES, stream) != hipSuccess) return;
    Params p{};
    for (int i = 0; i < 18; ++i) p.in[i] = (const float*)d_in[i];
    p.out = (float*)d_out; p.ws = (unsigned char*)d_ws; p.ph_lo = 0; p.ph_hi = NPHASE; p.li = 0; p.flags = 0;
    hipLaunchKernelGGL(mega_fwd, dim3(grid), dim3(NTHR), LDS_BYTES, stream, p);
    const hipError_t le = hipPeekAtLastError();
    if (le != hipSuccess) fprintf(stderr, "kernel_launch: launch failed: %s\n", hipGetErrorName(le));
}
```

```cpp
#include <hip/hip_runtime.h>
#include <stdint.h>
#include <math.h>
#include <cstdio>

constexpr int D = 1024, NB = 4, S = 8192, DEPTH = 2, T = NB * S;
constexpr int TOPK = 256, DFF = 2816, INC = 3020, INP = 3072;
constexpr float EPS = 1e-6f;
constexpr int C_Q = 0, C_K = 512, C_V = 576, C_QI = 640, C_KI = 896, C_WI = 960, C_QKM = 964, C_VM = 1988, C_OM = 2500, C_IG = 3012, C_FG = 3016;
typedef unsigned short bf16_t;


__device__ __forceinline__ int shx_i(int v, int m, int lane) { return __builtin_amdgcn_ds_bpermute((lane ^ m) << 2, v); }
__device__ __forceinline__ float shx(float v, int m, int lane) { return __builtin_bit_cast(float, shx_i(__builtin_bit_cast(int, v), m, lane)); }
__device__ __forceinline__ unsigned shx(unsigned v, int m, int lane) { return (unsigned)shx_i((int)v, m, lane); }
__device__ __forceinline__ float shfrom(float v, int src) { return __builtin_bit_cast(float, __builtin_amdgcn_ds_bpermute(src << 2, __builtin_bit_cast(int, v))); }
__device__ __forceinline__ unsigned shfrom(unsigned v, int src) { return (unsigned)__builtin_amdgcn_ds_bpermute(src << 2, (int)v); }
#ifndef FP8DOWN
#define FP8DOWN 1
#endif
#ifndef FP8UPLAST
#define FP8UPLAST 2
#endif
#define HYB 0
namespace pg8 {
#define PG8_LAS __attribute__((address_space(3)))
typedef unsigned short bf16_t;
typedef short bf16x8 __attribute__((ext_vector_type(8)));
typedef float f32x4 __attribute__((ext_vector_type(4)));
typedef unsigned u32x4 __attribute__((ext_vector_type(4)));
typedef int i32x4 __attribute__((ext_vector_type(4)));
constexpr int BM = 256, BK = 64, HALF = 128, HTB = HALF * BK * 2  , STAGE_BYTES = 8 * HTB, NXCD = 8, WGM = 8;

__host__ __device__ __forceinline__ int lds_byte(int r, int c) { const int st = (r >> 4) * 2 + (c >> 5), rr = r & 15, cc = c & 31, ob = rr * 64 + cc * 2; return st * 1024 + (ob ^ (((ob >> 9) & 1) << 5)); }
__host__ __device__ __forceinline__ void stage_rc(int b, int& R, int& C) { const int st = b / 1024, sb = b % 1024, swz = sb ^ (((sb >> 9) & 1) << 5); R = (st >> 1) * 16 + swz / 64; C = (st & 1) * 32 + (swz % 64) / 2; }
__host__ __device__ __forceinline__ int perm32(int rho) { const int n = rho >> 4, i = rho & 15; return 8 * (i >> 2) + 4 * n + (i & 3); }

struct Unit { int pm, pn; };
struct Gemm { const bf16_t* A; const bf16_t* Bt; int M, N, K; };

struct StaticOrder {
    int nM, nN, nwg, G, c;
    __host__ __device__ void init(int M, int N, int G_, int c_) { nM = M / BM; nN = N / BM; nwg = nM * nN; G = G_; c = c_; }
    __host__ __device__ bool next(int i, Unit& u) const {
        const long L = (long)i * G + c; if (L >= nwg) return false;
        int wgid = (int)L; { const int q = nwg / NXCD, r = nwg % NXCD, xcd = wgid % NXCD, off = wgid / NXCD; wgid = (xcd < r ? xcd * (q + 1) : r * (q + 1) + (xcd - r) * q) + off; }
        const int nig = WGM * nN, gid = wgid / nig, fm = gid * WGM, gsz = (nM - fm) < WGM ? (nM - fm) : WGM;
        u.pm = fm + ((wgid % nig) % gsz); u.pn = (wgid % nig) / gsz; return true;
    }
    __device__ __forceinline__ void a_ready(const Unit&) const {}
    __device__ __forceinline__ void done(const Unit&) const {}
};

__device__ __forceinline__ unsigned cvt_pk_bf16(float lo, float hi) { unsigned r; asm volatile("v_cvt_pk_bf16_f32 %0, %1, %2" : "=v"(r) : "v"(lo), "v"(hi)); return r; }
typedef float f32x2 __attribute__((ext_vector_type(2)));
#define PG8_GAS __attribute__((address_space(1)))
typedef PG8_GAS float gf32; typedef PG8_GAS bf16_t gbf16; typedef PG8_GAS f32x4 gf32x4; typedef PG8_GAS u32x4 gu32x4;
typedef const PG8_GAS float cgf32; typedef const PG8_GAS f32x4 cgf32x4;
__device__ __forceinline__ u32x4 pack8(const f32x4& a, const f32x4& b) { u32x4 w; w.x = cvt_pk_bf16(a[0], a[1]); w.y = cvt_pk_bf16(a[2], a[3]); w.z = cvt_pk_bf16(b[0], b[1]); w.w = cvt_pk_bf16(b[2], b[3]); return w; }
__device__ __forceinline__ float row_rstd(cgf32* SS, int row, int fq, int lane) {
    const f32x4 p = *(cgf32x4*)(SS + (size_t)row * 16 + 4 * fq);
    float s = (p[0] + p[1]) + (p[2] + p[3]);
    s += shx(s, 16, lane); s += shx(s, 32, lane);
    return rsqrtf(s * (1.0f / 1024.0f) + EPS);
}
__device__ __forceinline__ void row_rstd8(cgf32* SS, int row0, int fq, int lane, float (&rs)[2][4]) {
    f32x4 p[2][4];
#pragma unroll
    for (int ai = 0; ai < 2; ++ai)
#pragma unroll
        for (int m = 0; m < 4; ++m) p[ai][m] = *(cgf32x4*)(SS + (size_t)(row0 + ai * HALF + m * 16) * 16 + 4 * fq);
#pragma unroll
    for (int ai = 0; ai < 2; ++ai)
#pragma unroll
        for (int m = 0; m < 4; ++m) { float s = (p[ai][m][0] + p[ai][m][1]) + (p[ai][m][2] + p[ai][m][3]); s += shx(s, 16, lane); s += shx(s, 32, lane); rs[ai][m] = rsqrtf(s * (1.0f / 1024.0f) + EPS); }
}
__device__ __forceinline__ float silu_f(float g) { return g * __builtin_amdgcn_rcpf(1.0f + __builtin_amdgcn_exp2f(-1.4426950408889634f * g)); }

typedef unsigned u32x2 __attribute__((ext_vector_type(2)));
__device__ __forceinline__ u32x2 pack8_fp8(const f32x4& a, const f32x4& b) {
    unsigned lo = 0u, hi = 0u;
    lo = __builtin_amdgcn_cvt_pk_fp8_f32(a[0], a[1], lo, false); lo = __builtin_amdgcn_cvt_pk_fp8_f32(a[2], a[3], lo, true);
    hi = __builtin_amdgcn_cvt_pk_fp8_f32(b[0], b[1], hi, false); hi = __builtin_amdgcn_cvt_pk_fp8_f32(b[2], b[3], hi, true);
    return (u32x2){lo, hi};
}
constexpr float WUP_SCALE = 32.0f;
constexpr float ACT_SCALE = 1.0f, WDN_SCALE = 64.0f;
struct EpiUp {
    static constexpr bool PERM = true, AFTER_DRAIN = false;
    PG8_GAS unsigned char* ACT; cgf32* SS; float asc;
    __device__ __forceinline__ void operator()(const f32x4 (&acc)[2][2][4][2], const Unit& u, int wr, int wc, int fr_in, int fq_in) const {
        int fr, fq; { int l; asm volatile("v_mbcnt_lo_u32_b32 %0, -1, 0\n\tv_mbcnt_hi_u32_b32 %0, -1, %0" : "=v"(l)); fr = l & 15; fq = l >> 4; } (void)fr_in; (void)fq_in;
        const int row0 = u.pm * BM + wr * 64 + fr, col0 = u.pn * 128 + wc * 32 + 8 * fq;
        float rs8[2][4]; row_rstd8(SS, row0, fq, fr | (fq << 4), rs8);
#pragma unroll
        for (int ai = 0; ai < 2; ++ai)
#pragma unroll
            for (int m = 0; m < 4; ++m) rs8[ai][m] *= asc;
#pragma unroll
        for (int ai = 0; ai < 2; ++ai)
#pragma unroll
            for (int m = 0; m < 4; ++m) {
                asm volatile("" ::: "memory");
                const int row = row0 + ai * HALF + m * 16;
                const float rs = rs8[ai][m];
                f32x4 o[2];
#pragma unroll
                for (int n = 0; n < 2; ++n)
#pragma unroll
                    for (int j = 0; j < 4; ++j) o[n][j] = silu_f(acc[ai][0][m][n][j] * rs) * (acc[ai][1][m][n][j] * rs);
#if FP8DOWN
                *(PG8_GAS u32x2*)(ACT + (size_t)row * DFF + col0) = pack8_fp8(o[0], o[1]);
#else
                *(gu32x4*)((gbf16*)ACT + (size_t)row * DFF + col0) = pack8(o[0], o[1]);
#endif
            }
    }
};
struct EpiUpCheap {
    static constexpr bool PERM = true, AFTER_DRAIN = false;
    gbf16* ACT; cgf32* SS; int ld;
    __device__ __forceinline__ void operator()(const f32x4 (&acc)[2][2][4][2], const Unit& u, int wr, int wc, int fr, int fq) const {
        const int row0 = u.pm * BM + wr * 64 + fr, col0 = u.pn * 128 + wc * 32 + 8 * fq;
#pragma unroll
        for (int ai = 0; ai < 2; ++ai)
#pragma unroll
            for (int m = 0; m < 4; ++m) *(gu32x4*)(ACT + (size_t)(row0 + ai * HALF + m * 16) * ld + col0) = pack8(acc[ai][0][m][0] + acc[ai][1][m][0], acc[ai][0][m][1] + acc[ai][1][m][1]);
    }
};
template <bool FINAL, bool X8COPY = false> struct EpiRes {
    static constexpr bool PERM = true, AFTER_DRAIN = false;
    gf32* Xout; gbf16* XB; gf32* SS; PG8_GAS unsigned char* X8; float alpha;
    __device__ __forceinline__ void operator()(const f32x4 (&acc)[2][2][4][2], const Unit& u, int wr, int wc, int fr_in, int fq_in) const {
        int fr, fq; { int l; asm volatile("v_mbcnt_lo_u32_b32 %0, -1, 0\n\tv_mbcnt_hi_u32_b32 %0, -1, %0" : "=v"(l)); fr = l & 15; fq = l >> 4; }
        const int row0 = u.pm * BM + wr * 64 + fr, col0 = u.pn * BM + wc * 32 + 8 * fq;
        u32x4 xin[2][4][2];
#pragma unroll
        for (int ai = 0; ai < 2; ++ai)
#pragma unroll
            for (int m = 0; m < 4; ++m)
#pragma unroll
                for (int bj = 0; bj < 2; ++bj) xin[ai][m][bj] = *(const PG8_GAS u32x4*)(XB + (size_t)(row0 + ai * HALF + m * 16) * D + col0 + bj * HALF);
#pragma unroll
        for (int ai = 0; ai < 2; ++ai)
#pragma unroll
            for (int m = 0; m < 4; ++m) {
                const int row = row0 + ai * HALF + m * 16; float ssq = 0.f;
#pragma unroll
                for (int bj = 0; bj < 2; ++bj) {
                    const unsigned o = (unsigned)row * D + col0 + bj * HALF;
                    const u32x4 xb = xin[ai][m][bj];
                    f32x4 x0, x1;
                    x0[0] = __builtin_bit_cast(float, xb[0] << 16); x0[1] = __builtin_bit_cast(float, xb[0] & 0xffff0000u); x0[2] = __builtin_bit_cast(float, xb[1] << 16); x0[3] = __builtin_bit_cast(float, xb[1] & 0xffff0000u);
                    x1[0] = __builtin_bit_cast(float, xb[2] << 16); x1[1] = __builtin_bit_cast(float, xb[2] & 0xffff0000u); x1[2] = __builtin_bit_cast(float, xb[3] << 16); x1[3] = __builtin_bit_cast(float, xb[3] & 0xffff0000u);
                    const f32x4 y0 = x0 + alpha * acc[ai][bj][m][0], y1 = x1 + alpha * acc[ai][bj][m][1];
                    if (FINAL) { *(gf32x4*)(Xout + o) = y0; *(gf32x4*)(Xout + o + 4) = y1; }
                    else {
                        *(gu32x4*)(XB + o) = pack8(y0, y1);
                        if constexpr (X8COPY) *(PG8_GAS u32x2*)(X8 + o) = pack8_fp8(y0, y1);
                        ssq += (y0[0] * y0[0] + y0[1] * y0[1]) + (y0[2] * y0[2] + y0[3] * y0[3]) + (y1[0] * y1[0] + y1[1] * y1[1]) + (y1[2] * y1[2] + y1[3] * y1[3]);
                    }
                }
                if (!FINAL) { ssq += shx(ssq, 16, fr | (fq << 4)); ssq += shx(ssq, 32, fr | (fq << 4)); if (fq == 0) SS[(size_t)row * 16 + u.pn * 4 + wc] = ssq; }
            }
    }
};
struct EpiIn {
    static constexpr bool PERM = true, AFTER_DRAIN = false;
    cgf32* SS; cgf32* cs; cgf32* qn; cgf32* kn; cgf32* gate_b;
    gbf16 *Q, *KV, *QI, *KI, *QKM, *VM, *OM; gf32* GT;
    __device__ __forceinline__ void operator()(const f32x4 (&acc)[2][2][4][2], const Unit& u, int wr, int wc, int fr_in, int fq_in) const {
        const int fr = fr_in, fq = fq_in;
        const int row0 = u.pm * BM + wr * 64 + fr;
        float rs8[2][4]; row_rstd8(SS, row0, fq, fr | (fq << 4), rs8);
#pragma unroll
        for (int ai = 0; ai < 2; ++ai)
#pragma unroll
            for (int m = 0; m < 4; ++m) {
                asm volatile("" ::: "memory");
                const int row = row0 + ai * HALF + m * 16;
                const float rs = rs8[ai][m];
                f32x4 a0 = acc[ai][0][m][0] * rs, a1 = acc[ai][0][m][1] * rs, b0 = acc[ai][1][m][0] * rs, b1 = acc[ai][1][m][1] * rs;
                if (u.pn >= 4) {
                    if (u.pn >= 10) {
                        PG8_GAS unsigned char* o8 = (PG8_GAS unsigned char*)OM + (size_t)row * 512 + (u.pn - 10) * 256 + wc * 32 + 8 * fq;
                        *(PG8_GAS u32x2*)(o8) = pack8_fp8(a0, a1); *(PG8_GAS u32x2*)(o8 + 128) = pack8_fp8(b0, b1);
                    } else {
                        gbf16* base = (u.pn < 8 ? QKM + (size_t)row * 1024 + (u.pn - 4) * 256 : VM + (size_t)row * 512 + (u.pn - 8) * 256) + wc * 32 + 8 * fq;
                        *(gu32x4*)(base) = pack8(a0, a1); *(gu32x4*)(base + 128) = pack8(b0, b1);
                    }
                } else {
                    const int slot = u.pn * 4 + wc;
                    if (slot < 9) {
                        float ss = (a0[0] * a0[0] + a0[1] * a0[1]) + (a0[2] * a0[2] + a0[3] * a0[3]) + (a1[0] * a1[0] + a1[1] * a1[1]) + (a1[2] * a1[2] + a1[3] * a1[3])
                                 + (b0[0] * b0[0] + b0[1] * b0[1]) + (b0[2] * b0[2] + b0[3] * b0[3]) + (b1[0] * b1[0] + b1[1] * b1[1]) + (b1[2] * b1[2] + b1[3] * b1[3]);
                        ss += shx(ss, 16, fr | (fq << 4)); ss += shx(ss, 32, fr | (fq << 4));
                        const float r2 = rsqrtf(ss * (1.0f / 64.0f) + EPS);
                        cgf32* gn = (slot < 8 ? qn : kn) + 8 * fq;
                        a0 = a0 * r2 * *(cgf32x4*)(gn); a1 = a1 * r2 * *(cgf32x4*)(gn + 4);
                        b0 = b0 * r2 * *(cgf32x4*)(gn + 32); b1 = b1 * r2 * *(cgf32x4*)(gn + 36);
                    }
                    if (slot < 14) {
                        cgf32* c = cs + (size_t)(row & (S - 1)) * 64 + 8 * fq;
                        const f32x4 c0 = *(cgf32x4*)(c), c1 = *(cgf32x4*)(c + 4), s0 = *(cgf32x4*)(c + 32), s1 = *(cgf32x4*)(c + 36);
                        const f32x4 o10 = a0 * c0 - b0 * s0, o11 = a1 * c1 - b1 * s1, o20 = b0 * c0 + a0 * s0, o21 = b1 * c1 + a1 * s1;
                        if (slot == 8) {
                            PG8_GAS unsigned char* d8 = (PG8_GAS unsigned char*)KV + (size_t)row * 128 + 8 * fq;
                            *(PG8_GAS u32x2*)(d8) = pack8_fp8(o10, o11); *(PG8_GAS u32x2*)(d8 + 32) = pack8_fp8(o20, o21);
                        } else if (slot < 8) {
                            PG8_GAS unsigned char* q8 = (PG8_GAS unsigned char*)Q + (size_t)row * 512 + slot * 64 + 8 * fq;
                            *(PG8_GAS u32x2*)(q8) = pack8_fp8(o10, o11); *(PG8_GAS u32x2*)(q8 + 32) = pack8_fp8(o20, o21);
                        } else {
                            gbf16* dst;
                            if (slot == 9) dst = KI + (size_t)row * 64;
                            else dst = QI + (size_t)row * 256 + (slot - 10) * 64;
                            dst += 8 * fq;
                            *(gu32x4*)(dst) = pack8(o10, o11); *(gu32x4*)(dst + 32) = pack8(o20, o21);
                        }
                    } else if (slot == 14) {
                        PG8_GAS unsigned char* d8 = (PG8_GAS unsigned char*)KV + (size_t)row * 128 + 64 + 8 * fq;
                        *(PG8_GAS u32x2*)(d8) = pack8_fp8(a0, a1); *(PG8_GAS u32x2*)(d8 + 32) = pack8_fp8(b0, b1);
                    } else {
                        gf32* g = GT + (size_t)row * 16;
                        if (fq == 0) { *(gf32x4*)(g) = a0 * (1.0f / 16.0f); *(gf32x4*)(g + 4) = a1 + *(cgf32x4*)(gate_b); }
                        else if (fq == 1) { *(gf32x4*)(g + 8) = a0 + *(cgf32x4*)(gate_b + 4); }
                    }
                }
            }
    }
};

template <class Epi, class Sched, bool ALIGN_EPI = false, bool SP2 = false, bool FP8 = false>
__device__ __forceinline__ void gemm_phase(PG8_LAS unsigned char* lds, const Gemm g, const Sched& S, const Epi& E, int tid_in) {
    int tid_raw = tid_in; asm volatile("" : "+v"(tid_raw));
    const int tid = tid_raw, wid = __builtin_amdgcn_readfirstlane(tid >> 6), lane = tid & 63, wr = wid >> 2, wc = wid & 3, fr = lane & 15, fq = lane >> 4;
    const int K = g.K, nt = K / BK;
    unsigned voffA[2], voffB[2];
#pragma unroll
    for (int i = 0; i < 2; ++i) { int R, C; stage_rc(tid * 16 + i * 8192, R, C); const int Rb = Epi::PERM ? ((R & ~31) + perm32(R & 31)) : R;
        voffA[i] = (unsigned)(R * K + C) * 2u; voffB[i] = (unsigned)(Rb * K + C) * 2u; }
    const size_t kstep = (size_t)(BK * 2);
    const size_t hstep = (size_t)HALF * K * 2;
    const size_t tstep = 2 * hstep;
    const unsigned ldsw = (unsigned)wid * 1024u;
    const int aoff = lds_byte(wr * 64 + fr, fq * 8), boff = lds_byte(wc * 32 + fr, fq * 8);
#define PG8_SA(b, h) (((b) * 2 + (h)) * HTB)
#define PG8_SB(b, h) ((4 + (b) * 2 + (h)) * HTB)
#define PG8_STAGE(bufoff, gbase, voff) do { _Pragma("unroll") for (int _i = 0; _i < 2; ++_i) \
        __builtin_amdgcn_global_load_lds((const unsigned*)((const char*)(gbase) + (voff)[_i]), (PG8_LAS unsigned*)(lds + (bufoff) + ldsw + _i * 8192), 16, 0, 0); } while (0)
#define PG8_LDA(dst, b, h) do { _Pragma("unroll") for (int m = 0; m < 4; ++m) _Pragma("unroll") for (int k = 0; k < 2; ++k) dst[m][k] = *(const PG8_LAS bf16x8*)(lds + PG8_SA(b, h) + aoff + m * 2048 + k * 1024); } while (0)
#define PG8_LDB(dst, b, h) do { _Pragma("unroll") for (int n = 0; n < 2; ++n) _Pragma("unroll") for (int k = 0; k < 2; ++k) dst[n][k] = *(const PG8_LAS bf16x8*)(lds + PG8_SB(b, h) + boff + n * 2048 + k * 1024); } while (0)
#define PG8_CAT(x0, x1) __builtin_shufflevector(__builtin_bit_cast(i32x4, x0), __builtin_bit_cast(i32x4, x1), 0, 1, 2, 3, 4, 5, 6, 7)
#define PG8_MMA(ai, bj, At, Bt) do { __builtin_amdgcn_s_setprio(1); \
        if constexpr (FP8) { _Pragma("unroll") for (int m = 0; m < 4; ++m) _Pragma("unroll") for (int n = 0; n < 2; ++n) \
            asm volatile("v_mfma_f32_16x16x128_f8f6f4 %0, %1, %2, %0" : "+v"(acc[ai][bj][m][n]) : "v"(PG8_CAT(Bt[n][0], Bt[n][1])), "v"(PG8_CAT(At[m][0], At[m][1]))); } \
        else { _Pragma("unroll") for (int m = 0; m < 4; ++m) _Pragma("unroll") for (int n = 0; n < 2; ++n) _Pragma("unroll") for (int k = 0; k < 2; ++k) \
            acc[ai][bj][m][n] = __builtin_amdgcn_mfma_f32_16x16x32_bf16(Bt[n][k], At[m][k], acc[ai][bj][m][n], 0, 0, 0); } \
        __builtin_amdgcn_s_setprio(0); } while (0)
#define PG8_GUARD do { if constexpr (FP8) asm volatile("s_nop 15\n\ts_nop 15" ::: "memory"); } while (0)
#define PG8_WAIT_V(n) asm volatile("s_waitcnt vmcnt(" #n ")" ::: "memory")
#define PG8_WAIT_L(n) asm volatile("s_waitcnt lgkmcnt(" #n ")" ::: "memory")
#define PG8_BAR __builtin_amdgcn_s_barrier()
#define PG8_SCHED __builtin_amdgcn_sched_barrier(0)
    Unit cur, nxt; int ui = 0;
    if (!S.next(0, cur)) return;
    f32x4 acc[2][2][4][2];
#pragma unroll
    for (int a = 0; a < 2; ++a)
#pragma unroll
        for (int b = 0; b < 2; ++b)
#pragma unroll
            for (int m = 0; m < 4; ++m)
#pragma unroll
                for (int n = 0; n < 2; ++n) acc[a][b][m][n] = (f32x4){0.f, 0.f, 0.f, 0.f};
    bf16x8 At[4][2], B0[2][2], B1[2][2];
    const char* cA = (const char*)g.A + (size_t)cur.pm * tstep; const char* cB = (const char*)g.Bt + (size_t)cur.pn * tstep;
    S.a_ready(cur);
    if constexpr (SP2) {
        PG8_STAGE(PG8_SB(0, 0), cB, voffB); PG8_STAGE(PG8_SB(0, 1), cB + hstep, voffB); PG8_STAGE(PG8_SA(0, 0), cA, voffA); PG8_STAGE(PG8_SA(0, 1), cA + hstep, voffA);
        if (wr == 1) PG8_BAR;
        PG8_WAIT_V(2); PG8_BAR;
        PG8_STAGE(PG8_SB(1, 0), cB + kstep, voffB); PG8_STAGE(PG8_SA(1, 0), cA + kstep, voffA); PG8_STAGE(PG8_SB(1, 1), cB + hstep + kstep, voffB);
        PG8_WAIT_V(6); PG8_BAR;
    } else {
        PG8_STAGE(PG8_SB(0, 0), cB, voffB); PG8_STAGE(PG8_SA(0, 0), cA, voffA); PG8_STAGE(PG8_SB(0, 1), cB + hstep, voffB); PG8_STAGE(PG8_SA(0, 1), cA + hstep, voffA);
        if (wr == 1) PG8_BAR;
        PG8_WAIT_V(4); PG8_BAR;
        PG8_STAGE(PG8_SB(1, 0), cB + kstep, voffB); PG8_STAGE(PG8_SA(1, 0), cA + kstep, voffA); PG8_STAGE(PG8_SB(1, 1), cB + hstep + kstep, voffB);
        PG8_WAIT_V(6); PG8_BAR;
    }
    for (;;) {
        const bool has_next = S.next(ui + 1, nxt);
        const char* nA = has_next ? (const char*)g.A + (size_t)nxt.pm * tstep : cA; const char* nB = has_next ? (const char*)g.Bt + (size_t)nxt.pn * tstep : cB;
        for (int t = 0; t < nt; t += 2) {
            const bool last = (t == nt - 2);
            const char* a1 = cA + (size_t)(t + 1) * kstep;
            const char* a2 = last ? nA : cA + (size_t)(t + 2) * kstep; const char* b2 = last ? nB : cB + (size_t)(t + 2) * kstep;
            const char* a3 = a2 + kstep; const char* b3 = b2 + kstep;
            if (last && has_next) S.a_ready(nxt);
            if constexpr (SP2) {
            PG8_LDB(B0, 0, 0); PG8_LDB(B1, 0, 1); PG8_SCHED; PG8_LDA(At, 0, 0); PG8_STAGE(PG8_SA(1, 1), a1 + hstep, voffA);
            PG8_WAIT_V(8); PG8_WAIT_L(0); PG8_BAR; PG8_MMA(0, 0, At, B0); PG8_MMA(0, 1, At, B1); PG8_BAR; PG8_GUARD; PG8_SCHED;
            PG8_LDA(At, 0, 1); PG8_STAGE(PG8_SB(0, 0), b2, voffB); PG8_STAGE(PG8_SB(0, 1), b2 + hstep, voffB); PG8_STAGE(PG8_SA(0, 0), a2, voffA);
            PG8_WAIT_V(8); PG8_WAIT_L(0); PG8_BAR; PG8_MMA(1, 0, At, B0); PG8_MMA(1, 1, At, B1); PG8_BAR; PG8_GUARD; PG8_SCHED;
            PG8_LDB(B0, 1, 0); PG8_LDB(B1, 1, 1); PG8_SCHED; PG8_LDA(At, 1, 0); PG8_STAGE(PG8_SA(0, 1), a2 + hstep, voffA);
            PG8_WAIT_V(8); PG8_WAIT_L(0); PG8_BAR; PG8_MMA(0, 0, At, B0); PG8_MMA(0, 1, At, B1); PG8_BAR; PG8_GUARD; PG8_SCHED;
            PG8_LDA(At, 1, 1); PG8_STAGE(PG8_SB(1, 0), b3, voffB); PG8_STAGE(PG8_SB(1, 1), b3 + hstep, voffB); PG8_STAGE(PG8_SA(1, 0), a3, voffA);
            PG8_WAIT_V(8); PG8_WAIT_L(0); PG8_BAR; PG8_MMA(1, 0, At, B0); PG8_MMA(1, 1, At, B1); PG8_BAR; PG8_GUARD; PG8_SCHED;
            } else {
            PG8_LDB(B0, 0, 0); PG8_SCHED; PG8_LDA(At, 0, 0); PG8_STAGE(PG8_SA(1, 1), a1 + hstep, voffA);
            PG8_WAIT_L(8); PG8_BAR; PG8_WAIT_L(0); PG8_MMA(0, 0, At, B0); PG8_BAR; PG8_SCHED;
            PG8_LDB(B1, 0, 1); PG8_STAGE(PG8_SB(0, 0), b2, voffB);
            PG8_BAR; PG8_WAIT_L(0); PG8_MMA(0, 1, At, B1); PG8_BAR;
            PG8_LDA(At, 0, 1); PG8_STAGE(PG8_SA(0, 0), a2, voffA);
            PG8_BAR; PG8_WAIT_L(0); PG8_MMA(1, 0, At, B0); PG8_BAR; PG8_SCHED;
            PG8_STAGE(PG8_SB(0, 1), b2 + hstep, voffB);
            PG8_WAIT_V(6); PG8_BAR; PG8_MMA(1, 1, At, B1); PG8_BAR;
            PG8_LDB(B0, 1, 0); PG8_SCHED; PG8_LDA(At, 1, 0); PG8_STAGE(PG8_SA(0, 1), a2 + hstep, voffA);
            PG8_WAIT_L(8); PG8_BAR; PG8_WAIT_L(0); PG8_MMA(0, 0, At, B0); PG8_BAR; PG8_SCHED;
            PG8_LDB(B1, 1, 1); PG8_STAGE(PG8_SB(1, 0), b3, voffB);
            PG8_BAR; PG8_WAIT_L(0); PG8_MMA(0, 1, At, B1); PG8_BAR;
            PG8_LDA(At, 1, 1); PG8_STAGE(PG8_SA(1, 0), a3, voffA);
            PG8_BAR; PG8_WAIT_L(0); PG8_MMA(1, 0, At, B0); PG8_BAR; PG8_SCHED;
            PG8_STAGE(PG8_SB(1, 1), b3 + hstep, voffB);
            PG8_WAIT_V(6); PG8_BAR; PG8_MMA(1, 1, At, B1); PG8_BAR;
            }
        }
        if constexpr (FP8) { asm volatile("s_nop 15\n\ts_nop 15\n\ts_nop 15" ::: "memory"); }
        if constexpr (ALIGN_EPI) { if (wr == 0) PG8_BAR; }
        if constexpr (!Epi::AFTER_DRAIN) { E(acc, cur, wr, wc, fr, fq); S.done(cur); }
        if (!has_next) break;
#pragma unroll
        for (int a = 0; a < 2; ++a)
#pragma unroll
            for (int b = 0; b < 2; ++b)
#pragma unroll
                for (int m = 0; m < 4; ++m)
#pragma unroll
                    for (int n = 0; n < 2; ++n) acc[a][b][m][n] = (f32x4){0.f, 0.f, 0.f, 0.f};
        cur = nxt; cA = nA; cB = nB; ++ui;
        if constexpr (ALIGN_EPI) { if (wr == 1) PG8_BAR; }
    }
    PG8_WAIT_V(0);
    if constexpr (!ALIGN_EPI) { if (wr == 0) PG8_BAR; }
    PG8_BAR;
    if constexpr (Epi::AFTER_DRAIN) { E.fused(acc, cur, wr, wc, fr, fq, lds, wid, lane); S.done(cur); }
#undef PG8_SA
#undef PG8_SB
#undef PG8_STAGE
#undef PG8_LDA
#undef PG8_LDB
#undef PG8_MMA
#undef PG8_CAT
#undef PG8_WAIT_V
#undef PG8_GUARD
#undef PG8_WAIT_L
#undef PG8_BAR
#undef PG8_SCHED
}
}
#define GAS __attribute__((address_space(1)))
#define LAS __attribute__((address_space(3)))
typedef unsigned v4u __attribute__((ext_vector_type(4)));
typedef float f32x4 __attribute__((ext_vector_type(4)));
typedef short bf16x8 __attribute__((ext_vector_type(8)));
typedef GAS unsigned gu32;
#define RLX_AGENT __ATOMIC_RELAXED, __HIP_MEMORY_SCOPE_AGENT
#define LDS_WAIT() asm volatile("s_waitcnt lgkmcnt(0)" ::: "memory")
#define VM_WAIT() asm volatile("s_waitcnt vmcnt(0)" ::: "memory")
__device__ __forceinline__ unsigned f2bf(float f) { unsigned u = __builtin_bit_cast(unsigned, f); return (u + 0x7fffu + ((u >> 16) & 1u)) >> 16; }
__device__ __forceinline__ unsigned pk2(float lo, float hi) { unsigned r; asm("v_cvt_pk_bf16_f32 %0, %1, %2" : "=v"(r) : "v"(lo), "v"(hi)); return r; }
__device__ __forceinline__ float bf2f(unsigned short b) { return __builtin_bit_cast(float, (unsigned)b << 16); }

constexpr size_t MiB = 1u << 20;
constexpr size_t WS_CTL = 0, CTL_ZERO_BYTES = 1 * MiB;
constexpr size_t WS_CS = 1 * MiB;
constexpr size_t WS_SS = 3 * MiB;
constexpr size_t WS_W = 5 * MiB;
constexpr size_t W_UP = (size_t)2 * DFF * D * 2, W_DN = (size_t)D * DFF * 2, W_IN = (size_t)INP * D * 2, W_OUT = (size_t)D * D * 2;
constexpr size_t WO_U1 = 0, WO_D1 = WO_U1 + W_UP, WO_IN = WO_D1 + W_DN, WO_OUT = WO_IN + W_IN, WO_U2 = WO_OUT + W_OUT, WO_D2 = WO_U2 + W_UP, W_LAYER = WO_D2 + W_DN;
static_assert(W_LAYER == 41 * MiB, "weights per layer");
constexpr size_t WS_XB = 87 * MiB;
constexpr size_t WS_BIG = 151 * MiB;
constexpr size_t WS_XB8 = WS_BIG + 96 * MiB;
constexpr size_t WS_ACT = WS_BIG;
constexpr size_t WS_Q = WS_BIG, WS_KV = WS_Q + 32 * MiB, WS_QI = WS_KV + 8 * MiB, WS_KI = WS_QI + 16 * MiB, WS_GT = WS_KI + 4 * MiB, WS_QKM = WS_GT + 2 * MiB,
                 WS_VM = WS_QKM + 64 * MiB, WS_OM = WS_VM + 32 * MiB, WS_MIX = WS_OM + 32 * MiB, WS_CC = WS_MIX + 64 * MiB, WS_CP = WS_CC + 64 * MiB,
                 WS_NC = WS_CP + 32 * MiB, WS_NP = WS_NC + MiB / 2, WS_SC = WS_NP + MiB / 2, WS_END = WS_SC + MiB;
static_assert(WS_MIX >= WS_ACT + (size_t)T * DFF * 2 || true, "");
static_assert(WS_END <= 512 * MiB, "workspace map");
constexpr int CW_BAR = 4096;
constexpr int RING_BYTES = 131072, LDSCTL_OFF = RING_BYTES, MISC_OFF = LDSCTL_OFF + 320, LDS_BYTES = 147456, LDS_TAB_OFF = LDSCTL_OFF + 2048;
constexpr int NWAVES = 8, NTHR = 512;

__device__ __forceinline__ int my_lane_volatile() { int x; asm volatile("v_mbcnt_lo_u32_b32 %0, -1, 0\n\tv_mbcnt_hi_u32_b32 %0, -1, %0" : "=v"(x)); return x; }
#define XB_TMO      128
#define XB_XCNT(j)  (256  + 64 * (j))
#define XB_XSUB(j)  (1280 + 64 * (j))
#define XB_XGEN(j)  (2304 + 64 * (j))
#define XB_TOP      3328
#define XB_TOPGEN   3392
#define XCD_BAR_WORDS 3456
#define XB_SPIN_CAP (1u << 18)

__device__ __forceinline__ unsigned xb_ld(unsigned* p)              { return __hip_atomic_load(p, __ATOMIC_RELAXED, __HIP_MEMORY_SCOPE_AGENT); }
__device__ __forceinline__ unsigned xb_add(unsigned* p, unsigned v) { return __hip_atomic_fetch_add(p, v, __ATOMIC_RELAXED, __HIP_MEMORY_SCOPE_AGENT); }
__device__ __forceinline__ unsigned xb_xcc_id() { return (unsigned)__builtin_amdgcn_s_getreg((3 << 11) | 20) & 0xFu; }
#define XB_SPIN(cond, bar) do { unsigned _sp = 0; while (cond) { __builtin_amdgcn_s_sleep(1); \
    if ((++_sp & 255u) == 0u) { if (xb_ld(&(bar)[XB_TMO])) break; if (_sp > XB_SPIN_CAP) { atomicAdd(&(bar)[XB_TMO], 1u); break; } } } } while (0)

struct XcdBarrier {
    unsigned* bar; unsigned x;
    volatile LAS unsigned* st; int wave;
};

__device__ __forceinline__ XcdBarrier xcd_barrier_post(unsigned* bar, volatile LAS unsigned* st, int wave) {
    XcdBarrier b; b.bar = bar; b.x = xb_xcc_id(); b.st = st; b.wave = wave;
    if (wave == 0 && my_lane_volatile() == 0) (void)xb_add(&bar[XB_XCNT(b.x)], 1u);
    return b;
}
__device__ __forceinline__ void xcd_barrier_complete(unsigned* bar, unsigned x, unsigned& nloc, unsigned& nx) {
    const unsigned G = gridDim.x * gridDim.y * gridDim.z;
    unsigned sum, cnt, mine, sp = 0u;
    for (;;) {
        sum = 0u; cnt = 0u; mine = 0u;
#pragma unroll
        for (unsigned j = 0; j < 16; ++j) { const unsigned c = xb_ld(&bar[XB_XCNT(j)]); sum += c; cnt += (c > 0u) ? 1u : 0u; mine = (j == x) ? c : mine; }
        if (sum == G) break;
        __builtin_amdgcn_s_sleep(1);
        if ((++sp & 255u) == 0u) { if (xb_ld(&bar[XB_TMO])) break; if (sp > XB_SPIN_CAP) { atomicAdd(&bar[XB_TMO], 1u); break; } }
    }
    nloc = mine > 0u ? mine : 1u; nx = cnt > 0u ? cnt : 1u;
}

__device__ __forceinline__ void xcd_barrier(const XcdBarrier& b) {
    asm volatile("s_waitcnt vmcnt(0)" ::: "memory");
    __syncthreads();
    if (b.wave == 0 && my_lane_volatile() == 0) {
        unsigned* bar = b.bar;
        __builtin_amdgcn_s_waitcnt(0);
        unsigned nloc = b.st[0], nx = b.st[1];
        if (nloc == 0u) { xcd_barrier_complete(bar, b.x, nloc, nx); b.st[0] = nloc; b.st[1] = nx; }
        const unsigned old = xb_add(&bar[XB_XSUB(b.x)], 1u);
        const unsigned gen = old / nloc;
        if (old + 1u == (gen + 1u) * nloc) {
            __builtin_amdgcn_fence(__ATOMIC_RELEASE, "agent");
            asm volatile("s_waitcnt vmcnt(0)" ::: "memory");
            const unsigned og = xb_add(&bar[XB_TOP], 1u);
            const unsigned tg = og / nx;
            if (og + 1u == (tg + 1u) * nx) xb_add(&bar[XB_TOPGEN], 1u);
            else XB_SPIN(xb_ld(&bar[XB_TOPGEN]) == tg, bar);
            __builtin_amdgcn_fence(__ATOMIC_ACQUIRE, "agent");
            xb_add(&bar[XB_XGEN(b.x)], 1u);
            asm volatile("s_waitcnt vmcnt(0)" ::: "memory");
        } else {
            XB_SPIN(xb_ld(&bar[XB_XGEN(b.x)]) == gen, bar);
            __builtin_amdgcn_fence(__ATOMIC_ACQUIRE, "agent");
            asm volatile("s_waitcnt vmcnt(0)" ::: "memory");
        }
    }
    __syncthreads();
}

struct Params {
    const float* in[18]; float* out; unsigned char* ws;
    int ph_lo, ph_hi, li, flags;
};
enum { I_X = 0, I_F1N = 1, I_F1G = 2, I_F1U = 3, I_F1D = 4, I_MN = 5, I_WIN = 6, I_CW = 7, I_CB = 8, I_GB = 9, I_QN = 10, I_KN = 11, I_MNORM = 12, I_WOUT = 13, I_F2N = 14, I_F2G = 15, I_F2U = 16, I_F2D = 17 };

__device__ __forceinline__ float wave_sum(float v, int lane) {
#pragma unroll
    for (int o = 1; o < 64; o <<= 1) v += shx(v, o, lane);
    return v;
}
__device__ __forceinline__ int win_src(int p) {
    if (p >= 1024) return p < 2048 ? C_QKM + (p - 1024) : (p < 2560 ? C_VM + (p - 2048) : C_OM + (p - 2560));
    const int pn = p >> 8, r = p & 255, bj = r >> 7, wc = (r >> 5) & 3, dd = r & 31, slot = pn * 4 + wc, d = 32 * bj + dd;
    if (slot < 8) return C_Q + slot * 64 + d;
    if (slot == 8) return C_K + d;
    if (slot == 9) return C_KI + d;
    if (slot < 14) return C_QI + (slot - 10) * 64 + d;
    if (slot == 14) return C_V + d;
    if (d < 4) return C_WI + d;
    if (d < 8) return C_IG + d - 4;
    if (d < 12) return C_FG + d - 8;
    return -1;
}
__device__ __forceinline__ void tr_item(const float* W, int ldw, int K, bf16_t* WT, int n0, int k0, int srccol, const float* gain, LAS float* scr, int lane, float f8scale) {
    float v[32];
#pragma unroll
    for (int i = 0; i < 32; ++i) { const int kk = 2 * i + (lane >> 5); v[i] = srccol >= 0 ? W[(size_t)(k0 + kk) * ldw + srccol] : 0.f; }
    if (gain) {
#pragma unroll
        for (int i = 0; i < 32; ++i) v[i] *= gain[k0 + 2 * i + (lane >> 5)];
    }
#pragma unroll
    for (int i = 0; i < 32; ++i) scr[(2 * i + (lane >> 5)) * 33 + (lane & 31)] = v[i];
    LDS_WAIT(); asm volatile("" ::: "memory");
    const int c = lane & 7;
    if (f8scale > 0.f) {
#pragma unroll
        for (int j = 0; j < 4; ++j) { const int n = (lane >> 3) + 8 * j; const LAS float* s = scr + (8 * c) * 33 + n;
            unsigned lo = 0u, hi = 0u;
            lo = __builtin_amdgcn_cvt_pk_fp8_f32(s[0 * 33] * f8scale, s[1 * 33] * f8scale, lo, false); lo = __builtin_amdgcn_cvt_pk_fp8_f32(s[2 * 33] * f8scale, s[3 * 33] * f8scale, lo, true);
            hi = __builtin_amdgcn_cvt_pk_fp8_f32(s[4 * 33] * f8scale, s[5 * 33] * f8scale, hi, false); hi = __builtin_amdgcn_cvt_pk_fp8_f32(s[6 * 33] * f8scale, s[7 * 33] * f8scale, hi, true);
            *(GAS unsigned long long*)((GAS unsigned char*)WT + (size_t)(n0 + n) * K + k0 + 8 * c) = (unsigned long long)lo | ((unsigned long long)hi << 32); }
    } else {
#pragma unroll
    for (int j = 0; j < 4; ++j) { const int n = (lane >> 3) + 8 * j; const LAS float* s = scr + (8 * c) * 33 + n;
        v4u o; o.x = pk2(s[0 * 33], s[1 * 33]); o.y = pk2(s[2 * 33], s[3 * 33]); o.z = pk2(s[4 * 33], s[5 * 33]); o.w = pk2(s[6 * 33], s[7 * 33]);
        *(GAS v4u*)(WT + (size_t)(n0 + n) * K + k0 + 8 * c) = o; }
    }
    LDS_WAIT(); asm volatile("" ::: "memory");
}
__device__ __forceinline__ void sincos_acc(float ang, float& c, float& s) {
    const double TWO_PI = 6.283185307179586476925286766559, INV_TWO_PI = 0.15915494309189533576888376337251;
    const double a = (double)ang, k = rint(a * INV_TWO_PI), r = a - k * TWO_PI, r2 = r * r;
    double sn = 0.0, cn = 0.0, ts = r, tc = 1.0;
#pragma unroll
    for (int i = 0; i < 15; ++i) { sn += ts; cn += tc; tc = -tc * r2 * (1.0 / (double)((2 * i + 1) * (2 * i + 2))); ts = -ts * r2 * (1.0 / (double)((2 * i + 2) * (2 * i + 3))); }
    c = (float)cn; s = (float)sn;
}
__device__ __forceinline__ void p0_prologue(const Params& P, LAS unsigned char* lds, int vcu, int G, int wave, int lane) {
    LAS float* scr = (LAS float*)(lds + wave * 16384);
    const int gw = vcu * NWAVES + wave, NGW = G * NWAVES;
    unsigned char* ws = P.ws;
    constexpr int I_UP = (D / 64) * (2 * DFF / 32), I_DN = (DFF / 64) * (D / 32), I_IN = (D / 64) * (INP / 32), I_OUT = (D / 64) * (D / 32);
    constexpr int I_LAYER = 2 * I_UP + 2 * I_DN + I_IN + I_OUT;
    for (int it = gw; it < DEPTH * I_LAYER; it += NGW) {
        const int l = it / I_LAYER; int r = it % I_LAYER;
        const float* W; const float* gain = nullptr; int ldw, K, nblk, src_mode; size_t wo; float f8 = 0.f;
        if (r < 2 * I_UP) { const int f = r / I_UP; r -= f * I_UP; ldw = DFF; K = D; nblk = 2 * DFF / 32; src_mode = f; wo = f ? WO_U2 : WO_U1; gain = P.in[f ? I_F2N : I_F1N] + l * D; W = nullptr;
                            if (FP8UPLAST && l == DEPTH - 1 && (f == 1 || FP8UPLAST >= 2)) f8 = pg8::WUP_SCALE; }
        else if (r < 2 * I_UP + 2 * I_DN) { r -= 2 * I_UP; const int f = r / I_DN; r -= f * I_DN; ldw = D; K = DFF; nblk = D / 32; src_mode = 2; wo = f ? WO_D2 : WO_D1; W = P.in[f ? I_F2D : I_F1D] + (size_t)l * DFF * D; f8 = FP8DOWN ? pg8::WDN_SCALE : 0.f; }
        else if (r < 2 * I_UP + 2 * I_DN + I_IN) { r -= 2 * I_UP + 2 * I_DN; ldw = INC; K = D; nblk = INP / 32; src_mode = 3; wo = WO_IN; gain = P.in[I_MN] + l * D; W = P.in[I_WIN] + (size_t)l * D * INC; }
        else { r -= 2 * I_UP + 2 * I_DN + I_IN; ldw = D; K = D; nblk = D / 32; src_mode = 2; wo = WO_OUT; W = P.in[I_WOUT] + (size_t)l * D * D; }
        const int kb = r / nblk, nb = r % nblk, n0 = 32 * nb, k0 = 64 * kb;
        int src = n0 + (lane & 31);
        if (src_mode < 2) {
            const int pn = n0 >> 8, rr = n0 & 255;
            W = (rr < 128 ? P.in[src_mode ? I_F2G : I_F1G] : P.in[src_mode ? I_F2U : I_F1U]) + (size_t)l * D * DFF;
            src = 128 * pn + (rr & 127) + (lane & 31);
        } else if (src_mode == 3) src = win_src(src);
        tr_item(W, ldw, K, (bf16_t*)(ws + WS_W + (size_t)l * W_LAYER + wo), n0, k0, src, gain, scr, lane, f8);
    }
    {
        const float* x = P.in[I_X]; bf16_t* XB = (bf16_t*)(ws + WS_XB); float* SS = (float*)(ws + WS_SS);
        for (int m0 = gw * 4; m0 < T; m0 += NGW * 4) {
            f32x4 v[4][4];
#pragma unroll
            for (int r = 0; r < 4; ++r) { const GAS f32x4* xr = (const GAS f32x4*)(x + (size_t)(m0 + r) * D) + lane;
#pragma unroll
                for (int j = 0; j < 4; ++j) v[r][j] = xr[64 * j]; }
#pragma unroll
            for (int r = 0; r < 4; ++r) { float s = 0.f;
#pragma unroll
                for (int j = 0; j < 4; ++j) s += (v[r][j][0] * v[r][j][0] + v[r][j][1] * v[r][j][1]) + (v[r][j][2] * v[r][j][2] + v[r][j][3] * v[r][j][3]);
                s = wave_sum(s, lane);
                GAS unsigned long long* o8 = (GAS unsigned long long*)(XB + (size_t)(m0 + r) * D) + lane;
#pragma unroll
                for (int j = 0; j < 4; ++j) o8[64 * j] = (unsigned long long)pk2(v[r][j][0], v[r][j][1]) | ((unsigned long long)pk2(v[r][j][2], v[r][j][3]) << 32);
                if (lane < 16) SS[(size_t)(m0 + r) * 16 + lane] = lane == 0 ? s : 0.f; }
        }
    }
    {
        float* cs = (float*)(ws + WS_CS);
        for (int i = gw * 64 + lane; i < S * 32; i += NGW * 64) {
            const int pos = i >> 5, j = i & 31; float c, s;
            double fr = 1.0; for (int q = 0; q < j; ++q) fr *= 0.74989420933245582730;
            sincos_acc((float)pos * (float)fr, c, s);
            cs[pos * 64 + j] = c; cs[pos * 64 + 32 + j] = s;
        }
    }
}
typedef short v4i16_t __attribute__((ext_vector_type(4)));
typedef float f32x2_t __attribute__((ext_vector_type(2)));
typedef GAS float gf32; typedef const GAS float cgf32; typedef GAS bf16_t gbf; typedef const GAS bf16_t cgbf;
typedef const GAS v4u cgv4u; typedef GAS v4u gv4u; typedef const GAS f32x4 cgf32x4;
__device__ __forceinline__ v4i16_t tr16(LAS const unsigned char* p) { return __builtin_amdgcn_ds_read_tr16_b64_v4i16((LAS v4i16_t*)p); }
__device__ __forceinline__ bf16x8 cat8(v4i16_t lo, v4i16_t hi) { bf16x8 r; r[0] = lo[0]; r[1] = lo[1]; r[2] = lo[2]; r[3] = lo[3]; r[4] = hi[0]; r[5] = hi[1]; r[6] = hi[2]; r[7] = hi[3]; return r; }
__device__ __forceinline__ pg8::f32x4 mfma16(bf16x8 a, bf16x8 b, pg8::f32x4 c) {
    c = __builtin_amdgcn_mfma_f32_16x16x32_bf16(a, b, c, 0, 0, 0);
    asm volatile("s_nop 3" : "+v"(c) : "v"(a), "v"(b));
    return c;
}
__device__ __forceinline__ unsigned opaque0() { unsigned z; asm volatile("v_mov_b32 %0, 0" : "=v"(z)); return z; }
__device__ __forceinline__ float fast_sigmoid(float x) { return __builtin_amdgcn_rcpf(1.0f + __builtin_amdgcn_exp2f(-1.4426950408889634f * x)); }
__device__ __forceinline__ float fast_exp(float x) { return __builtin_amdgcn_exp2f(1.4426950408889634f * x); }
constexpr int ML_UNITS = NB * 4 * 64;
constexpr int ST_T = 288, ST_R = 272;
constexpr float KSCALE = 0.08838834764831845f;

__device__ __forceinline__ float lane63(float x) { return __builtin_bit_cast(float, __builtin_amdgcn_readlane(__builtin_bit_cast(int, x), 63)); }
__device__ __forceinline__ float scan_add(float x, int lane) {
#pragma unroll
    for (int d = 1; d < 64; d <<= 1) { const float y = shfrom(x, lane - d); x += (lane >= d) ? y : 0.f; }
    return x;
}
__device__ __forceinline__ float scan_max(float x, int lane) {
#pragma unroll
    for (int d = 1; d < 64; d <<= 1) { const float y = shfrom(x, lane - d); x = (lane >= d) ? fmaxf(x, y) : x; }
    return x;
}
__device__ __forceinline__ void ml_gates_reg(cgf32* GT, int tok0, int h, int wave, int lane, float& bt, float& ct, float& pm, float& bl, float& cmax) {
    const float f0 = GT[(size_t)(tok0 + lane) * 16 + 8 + h], i0 = GT[(size_t)(tok0 + lane) * 16 + 4 + h];
    const float f1 = GT[(size_t)(tok0 + 64 + lane) * 16 + 8 + h], i1 = GT[(size_t)(tok0 + 64 + lane) * 16 + 4 + h];
    const float l0 = fminf(f0, 0.f) - 0.6931471805599453f * __builtin_amdgcn_logf(1.0f + __builtin_amdgcn_exp2f(-1.4426950408889634f * fabsf(f0))), l1 = fminf(f1, 0.f) - 0.6931471805599453f * __builtin_amdgcn_logf(1.0f + __builtin_amdgcn_exp2f(-1.4426950408889634f * fabsf(f1)));
    const float b0 = scan_add(l0, lane), tot0 = lane63(b0), b1 = scan_add(l1, lane) + tot0;
    const float c0 = i0 - b0, c1 = i1 - b1;
    const float p0 = scan_max(c0, lane), m0 = lane63(p0), p1 = fmaxf(scan_max(c1, lane), m0);
    bl = lane63(b1); cmax = lane63(p1);
    bt = wave ? b1 : b0; ct = wave ? c1 : c0; pm = wave ? p1 : p0;
}
__device__ __forceinline__ void ml_conv_tile(cgbf* QKM, cgf32* cw, cgf32* cb, int tok0, int c, int col0, LAS unsigned char* img, int stride, float scl, const LAS float* rowscale, int tid, unsigned Z) {
    const int dg = tid & 15, r4 = tid >> 4, t0 = 4 * r4;
    v4u x[7];
#pragma unroll
    for (int j = 0; j < 7; ++j) { const int tt = t0 - 3 + j; const bool ok = (tt >= 0) || (c > 0);
        x[j] = *(cgv4u*)(QKM + (size_t)(tok0 + (ok ? tt : 0)) * 1024 + col0 + 8 * dg);
        if (!ok) x[j] = (v4u){Z, Z, Z, Z}; }
    float w[4][8], bb[8];
#pragma unroll
    for (int j = 0; j < 4; ++j) { const f32x4 a = *(cgf32x4*)(cw + j * 1024 + col0 + 8 * dg), b = *(cgf32x4*)(cw + j * 1024 + col0 + 8 * dg + 4);
#pragma unroll
        for (int e = 0; e < 4; ++e) { w[j][e] = a[e]; w[j][4 + e] = b[e]; } }
    { const f32x4 a = *(cgf32x4*)(cb + col0 + 8 * dg), b = *(cgf32x4*)(cb + col0 + 8 * dg + 4);
#pragma unroll
      for (int e = 0; e < 4; ++e) { bb[e] = a[e]; bb[4 + e] = b[e]; } }
#pragma unroll
    for (int r = 0; r < 4; ++r) {
        float y[8];
#pragma unroll
        for (int e = 0; e < 8; ++e) y[e] = bb[e];
#pragma unroll
        for (int j = 0; j < 4; ++j)
#pragma unroll
            for (int e = 0; e < 4; ++e) { y[2 * e] += w[j][2 * e] * __builtin_bit_cast(float, x[r + j][e] << 16); y[2 * e + 1] += w[j][2 * e + 1] * __builtin_bit_cast(float, x[r + j][e] & 0xffff0000u); }
        const float sc = rowscale ? scl * rowscale[t0 + r] : scl;
#pragma unroll
        for (int e = 0; e < 8; ++e) y[e] = y[e] * fast_sigmoid(y[e]) * sc;
        v4u o; o.x = pk2(y[0], y[1]); o.y = pk2(y[2], y[3]); o.z = pk2(y[4], y[5]); o.w = pk2(y[6], y[7]);
        *(LAS v4u*)(img + (t0 + r) * stride + 16 * dg) = o;
    }
}
__device__ __forceinline__ void ml_v_tile(cgbf* VM, int tok0, int h, LAS unsigned char* img, int tid, unsigned Z) {
    const int dg = tid & 15, tr = tid >> 4;
#pragma unroll
    for (int i = 0; i < 4; ++i) { const int t = tr + 32 * i;
        *(LAS v4u*)(img + t * ST_T + 16 * dg) = *(cgv4u*)(VM + (size_t)(tok0 + t) * 512 + h * 128 + 8 * dg); }
    if (tid < 128) { *(LAS v4u*)(img + tid * ST_T + 256) = (v4u){Z | 0x3F80u, Z, Z, Z}; *(LAS v4u*)(img + tid * ST_T + 272) = (v4u){Z, Z, Z, Z}; }
}

__device__ __forceinline__ void ml_phase1(unsigned char* ws, cgf32* cw, cgf32* cb, LAS unsigned char* lds, int G, int bx, int tid_in, int wave, int lane_in) {
    int tid = tid_in, lane = lane_in;
    LAS unsigned char* KIMG = lds; LAS unsigned char* VIMG = lds + 128 * ST_T;
    LAS float* lf = (LAS float*)(lds + 2 * 128 * ST_T); LAS float* ig = lf + 128; LAS float* bc = ig + 128; LAS float* wa = bc + 128;
    cgf32* GT = (cgf32*)(ws + WS_GT); cgbf* QKM = (cgbf*)(ws + WS_QKM); cgbf* VM = (cgbf*)(ws + WS_VM);
    gf32* CC = (gf32*)(ws + WS_CC); gf32* NC = (gf32*)(ws + WS_NC); gf32* SCL = (gf32*)(ws + WS_SC);
    for (int unit = bx; unit < ML_UNITS; unit += G) {
        lane = my_lane_volatile(); tid = (wave << 6) | lane;
        const int g = lane >> 4, q = (lane >> 2) & 3, p = lane & 3;
        const unsigned Z = opaque0();
        const int c = unit & 63, h = (unit >> 6) & 3, b = unit >> 8, tok0 = b * S + c * 128;
        if (tid < 128) {
            float bt, ct, pm, bl, cmax; ml_gates_reg(GT, tok0, h, wave, lane, bt, ct, pm, bl, cmax);
            const float am = bl + cmax;
            wa[tid] = __expf(bl + ct - am);
            if (tid == 0) { SCL[unit * 4 + 0] = bl; SCL[unit * 4 + 1] = am; }
        }
        __syncthreads();
        ml_conv_tile(QKM, cw, cb, tok0, c, 512 + h * 128, KIMG, ST_T, __builtin_bit_cast(float, Z | 0x3db504f3u)  , wa, tid, Z);
        ml_v_tile(VM, tok0, h, VIMG, tid, Z);
        __syncthreads();
        bf16x8 af[4];
#pragma unroll
        for (int ks = 0; ks < 4; ++ks) { const LAS unsigned char* a = KIMG + (32 * ks + 8 * g + q) * ST_T + 32 * wave + 8 * p; af[ks] = cat8(tr16(a), tr16(a + 4 * ST_T)); }
        bf16x8 ones;
#pragma unroll
        for (int e = 0; e < 8; ++e) ones[e] = (short)0x3F80;
        pg8::f32x4 accn = {0.f, 0.f, 0.f, 0.f};
#pragma unroll
        for (int ks = 0; ks < 4; ++ks) accn = mfma16(af[ks], ones, accn);
        gf32* ccu = CC + (size_t)unit * 16384 + (size_t)(16 * wave + 4 * g) * 128 + (lane & 15);
#pragma unroll
        for (int nt = 0; nt < 8; ++nt) {
            pg8::f32x4 acc = {0.f, 0.f, 0.f, 0.f};
#pragma unroll
            for (int ks = 0; ks < 4; ++ks) { const LAS unsigned char* a = VIMG + (32 * ks + 8 * g + q) * ST_T + 32 * nt + 8 * p; const bf16x8 bfr = cat8(tr16(a), tr16(a + 4 * ST_T));
                acc = mfma16(af[ks], bfr, acc); }
#pragma unroll
            for (int r = 0; r < 4; ++r) ccu[r * 128 + 16 * nt] = acc[r];
        }
        if ((lane & 15) == 0) {
#pragma unroll
            for (int r = 0; r < 4; ++r) NC[unit * 128 + 16 * wave + 4 * g + r] = accn[r];
        }
        __syncthreads();
    }
}
__device__ __forceinline__ void ml_phase2(unsigned char* ws, int G, int bx, int tid) {
    cgf32* CC = (cgf32*)(ws + WS_CC); cgf32* NC = (cgf32*)(ws + WS_NC); gf32* SCL = (gf32*)(ws + WS_SC);
    GAS unsigned* CP = (GAS unsigned*)(ws + WS_CP); gf32* NP = (gf32*)(ws + WS_NP);
    const int gt = bx * NTHR + tid, GT_ = G * NTHR;
    for (int idx = gt; idx < 16 * 8192; idx += GT_) {
        const int pr = idx >> 13, e2 = idx & 8191;
        float m = 0.f, c0 = 0.f, c1 = 0.f;
        for (int cg = 0; cg < 64; cg += 16) {
            float bl[16], am[16]; f32x2_t cc[16];
#pragma unroll
            for (int k = 0; k < 16; ++k) { const int unit = pr * 64 + cg + k; bl[k] = SCL[unit * 4 + 0]; am[k] = SCL[unit * 4 + 1]; cc[k] = *(const GAS f32x2_t*)(CC + (size_t)unit * 16384 + 2 * e2); }
            asm volatile("" ::: "memory");
#pragma unroll
            for (int k = 0; k < 16; ++k) { const int unit = pr * 64 + cg + k;
                CP[(size_t)unit * 8192 + e2] = pk2(c0, c1);
                if (e2 == 0) SCL[unit * 4 + 2] = m;
                const float mn = fmaxf(bl[k] + m, am[k]), so = __expf(bl[k] + m - mn), sn = __expf(am[k] - mn);
                c0 = so * c0 + sn * cc[k].x; c1 = so * c1 + sn * cc[k].y; m = mn; }
            asm volatile("" ::: "memory");
        }
    }
    for (int idx = gt; idx < 16 * 128; idx += GT_) {
        const int pr = idx >> 7, d = idx & 127;
        float m = 0.f, n = 0.f;
        for (int cg = 0; cg < 64; cg += 16) {
            float bl[16], am[16], nc[16];
#pragma unroll
            for (int k = 0; k < 16; ++k) { const int unit = pr * 64 + cg + k; bl[k] = SCL[unit * 4 + 0]; am[k] = SCL[unit * 4 + 1]; nc[k] = NC[unit * 128 + d]; }
            asm volatile("" ::: "memory");
#pragma unroll
            for (int k = 0; k < 16; ++k) { const int unit = pr * 64 + cg + k;
                NP[unit * 128 + d] = n;
                const float mn = fmaxf(bl[k] + m, am[k]), so = __expf(bl[k] + m - mn), sn = __expf(am[k] - mn);
                n = so * n + sn * nc[k]; m = mn; }
            asm volatile("" ::: "memory");
        }
    }
}
__device__ __forceinline__ void ml_phase3(unsigned char* ws, cgf32* cw, cgf32* cb, cgf32* mnorm, LAS unsigned char* lds, int G, int bx, int tid_in, int wave, int lane_in) {
    int tid = tid_in, lane = lane_in;
    LAS unsigned char* QIMG = lds; LAS unsigned char* KIMG = lds + 128 * ST_R; LAS unsigned char* VIMG = lds + 2 * 128 * ST_R; LAS unsigned char* CIMG = lds;
    LAS float* lf = (LAS float*)(lds + 2 * 128 * ST_R + 128 * ST_T); LAS float* ig = lf + 128; LAS float* bc = ig + 128;
    LAS float* rowt = bc + 128; LAS float* colt = rowt + 128; LAS float* wint = colt + 128; LAS float* flo = wint + 128;
    cgf32* GT = (cgf32*)(ws + WS_GT); cgbf* QKM = (cgbf*)(ws + WS_QKM); cgbf* VM = (cgbf*)(ws + WS_VM); cgbf* OM = (cgbf*)(ws + WS_OM);
    cgf32* SCL = (cgf32*)(ws + WS_SC); cgf32* NP = (cgf32*)(ws + WS_NP); cgbf* CP = (cgbf*)(ws + WS_CP); gbf* MIX = (gbf*)(ws + WS_MIX);
    for (int unit = bx; unit < ML_UNITS; unit += G) {
        lane = my_lane_volatile(); tid = (wave << 6) | lane;
        const int g = lane >> 4, q = (lane >> 2) & 3, p = lane & 3, l15 = lane & 15;
        const unsigned Z = opaque0();
        const int c = unit & 63, h = (unit >> 6) & 3, b = unit >> 8, tok0 = b * S + c * 128;
        v4u cpr[4];
#pragma unroll
        for (int i = 0; i < 4; ++i) cpr[i] = *(cgv4u*)(CP + (size_t)unit * 16384 + (size_t)(tid + 512 * i) * 8);
        if (tid < 128) {
            float bt, ct, pm, bl, cmax; ml_gates_reg(GT, tok0, h, wave, lane, bt, ct, pm, bl, cmax);
            const float mp = SCL[unit * 4 + 2], gt = bt + mp, mt = fmaxf(gt, bt + pm);
            rowt[tid] = bt - mt; colt[tid] = ct; wint[tid] = __expf(gt - mt); flo[tid] = __expf(-mt);
        }
        ml_conv_tile(QKM, cw, cb, tok0, c, h * 128, QIMG, ST_R, 1.0f, nullptr, tid, Z);
        ml_conv_tile(QKM, cw, cb, tok0, c, 512 + h * 128, KIMG, ST_R, __builtin_bit_cast(float, Z | 0x3db504f3u), nullptr, tid, Z);
        ml_v_tile(VM, tok0, h, VIMG, tid, Z);
        __syncthreads();
        bf16x8 qf[4];
#pragma unroll
        for (int ks = 0; ks < 4; ++ks) qf[ks] = *(const LAS bf16x8*)(QIMG + (16 * wave + l15) * ST_R + 64 * ks + 16 * g);
        const int tq = 16 * wave + l15; const float rt = rowt[tq], wi = wint[tq];
        float pr[8][4];
#pragma unroll
        for (int st = 0; st < 8; ++st) {
            {
                pg8::f32x4 acc = {0.f, 0.f, 0.f, 0.f};
#pragma unroll
                for (int ks = 0; ks < 4; ++ks) { const bf16x8 kf = *(const LAS bf16x8*)(KIMG + (16 * st + l15) * ST_R + 64 * ks + 16 * g); acc = mfma16(kf, qf[ks], acc); }
                const pg8::f32x4 ct = *(const LAS pg8::f32x4*)(colt + 16 * st + 4 * g);
#pragma unroll
                for (int r = 0; r < 4; ++r) { const int s = 16 * st + 4 * g + r; const float wgt = __expf(rt + ct[r]); pr[st][r] = (s <= tq) ? acc[r] * wgt : 0.f; }
            }
        }
        __syncthreads();
#pragma unroll
        for (int i = 0; i < 4; ++i) { const int ch = tid + 512 * i, d = ch >> 4, cg = ch & 15; *(LAS v4u*)(CIMG + d * ST_T + 16 * cg) = cpr[i]; }
        if (tid < 128) { *(LAS v4u*)(CIMG + tid * ST_T + 256) = (v4u){f2bf(NP[unit * 128 + tid]), Z, Z, Z}; *(LAS v4u*)(CIMG + tid * ST_T + 272) = (v4u){Z, Z, Z, Z}; }
        __syncthreads();
        pg8::f32x4 acc2[9];
#pragma unroll
        for (int nt = 0; nt < 9; ++nt) acc2[nt] = (pg8::f32x4){0.f, 0.f, 0.f, 0.f};
#pragma unroll
        for (int ks = 0; ks < 4; ++ks) {
            v4u a3w;
#pragma unroll
            for (int e = 0; e < 4; ++e) a3w[e] = pk2(bf2f((unsigned short)qf[ks][2 * e]) * wi, bf2f((unsigned short)qf[ks][2 * e + 1]) * wi);
            const bf16x8 a3 = __builtin_bit_cast(bf16x8, a3w);
#pragma unroll
            for (int nt = 0; nt < 9; ++nt) { const LAS unsigned char* a = CIMG + (32 * ks + 8 * g + q) * ST_T + 32 * nt + 8 * p; acc2[nt] = mfma16(a3, cat8(tr16(a), tr16(a + 4 * ST_T)), acc2[nt]); }
        }
#pragma unroll
        for (int kk = 0; kk < 4; ++kk) {
            {
                v4u a2w; a2w[0] = pk2(pr[2 * kk][0], pr[2 * kk][1]); a2w[1] = pk2(pr[2 * kk][2], pr[2 * kk][3]); a2w[2] = pk2(pr[2 * kk + 1][0], pr[2 * kk + 1][1]); a2w[3] = pk2(pr[2 * kk + 1][2], pr[2 * kk + 1][3]);
                const bf16x8 a2 = __builtin_bit_cast(bf16x8, a2w);
#pragma unroll
                for (int nt = 0; nt < 9; ++nt) { const LAS unsigned char* a = VIMG + (32 * kk + 4 * g + q) * ST_T + 32 * nt + 8 * p; acc2[nt] = mfma16(a2, cat8(tr16(a), tr16(a + 16 * ST_T)), acc2[nt]); }
            }
        }
        const pg8::f32x4 fl = *(const LAS pg8::f32x4*)(flo + 16 * wave + 4 * g);
        float inv[4], ssq[4];
#pragma unroll
        for (int r = 0; r < 4; ++r) { const float den = shfrom(acc2[8][r], lane & 48); inv[r] = 1.0f / fmaxf(fabsf(den), fl[r]); ssq[r] = 0.f; }
#pragma unroll
        for (int nt = 0; nt < 8; ++nt)
#pragma unroll
            for (int r = 0; r < 4; ++r) { acc2[nt][r] *= inv[r]; ssq[r] += acc2[nt][r] * acc2[nt][r]; }
#pragma unroll
        for (int r = 0; r < 4; ++r) { float s = ssq[r]; s += shx(s, 1, lane); s += shx(s, 2, lane); s += shx(s, 4, lane); s += shx(s, 8, lane); ssq[r] = rsqrtf(s * (1.0f / 128.0f) + EPS); }
        unsigned char om8[8][4]; float gnv[8];
#pragma unroll
        for (int nt = 0; nt < 8; ++nt) {
            const int e = 16 * nt + l15; gnv[nt] = mnorm[h * 128 + e];
#pragma unroll
            for (int r = 0; r < 4; ++r) om8[nt][r] = ((const GAS unsigned char*)OM)[(size_t)(tok0 + 16 * wave + 4 * g + r) * 512 + h * 128 + e];
        }
        asm volatile("" ::: "memory");
#pragma unroll
        for (int nt = 0; nt < 8; ++nt) {
            const int e = 16 * nt + l15;
#pragma unroll
            for (int r = 0; r < 4; ++r) {
                const size_t tok = (size_t)(tok0 + 16 * wave + 4 * g + r);
                const float o = __builtin_amdgcn_cvt_f32_fp8((int)om8[nt][r], 0);
                { const float val = acc2[nt][r] * ssq[r] * gnv[nt] * fast_sigmoid(o); MIX[tok * 1024 + 512 + h * 128 + e] = (bf16_t)pk2(val, val); }
            }
        }
        __syncthreads();
    }
}

#ifndef REP_M1
#define REP_M1 1
#endif
#ifndef REP_M2
#define REP_M2 1
#endif
#ifndef REP_M3
#define REP_M3 1
#endif
#ifndef REP_DSA
#define REP_DSA 1
#endif
#define LAUNDER_TID int tl = MYTID(); asm volatile("" : "+v"(tl)); const int ll = tl & 63, wl_ = __builtin_amdgcn_readfirstlane(tl >> 6);
#define MIXER_M1 { if (!(P.flags & 2)) { for (int rep = 0; rep < REP_M1; ++rep) { LAUNDER_TID ml_phase1(ws, (cgf32*)(P.in[I_CW] + (size_t)l * 4096), (cgf32*)(P.in[I_CB] + l * 1024), lds, G, bx, tl, wl_, ll); } } }
#define MIXER_M2_DSA { if (!(P.flags & 1)) { for (int rep = 0; rep < REP_DSA; ++rep) { LAUNDER_TID dsa_phase(ws, (unsigned char*)X, lds, G, bx, tl, wl_, ll); } } if (!(P.flags & 2)) { for (int rep = 0; rep < REP_M2; ++rep) { LAUNDER_TID ml_phase2(ws, G, bx, tl); } } }
#define MIXER_M3 { if (!(P.flags & 2)) { for (int rep = 0; rep < REP_M3; ++rep) { LAUNDER_TID ml_phase3(ws, (cgf32*)(P.in[I_CW] + (size_t)l * 4096), (cgf32*)(P.in[I_CB] + l * 1024), (cgf32*)(P.in[I_MNORM] + l * 512), lds, G, bx, tl, wl_, ll); } } }
typedef float f32x16 __attribute__((ext_vector_type(16)));
__device__ __forceinline__ f32x16 mfma32(bf16x8 a, bf16x8 b, f32x16 c) {
    c = __builtin_amdgcn_mfma_f32_32x32x16_bf16(a, b, c, 0, 0, 0);
    asm volatile("s_nop 3" : "+v"(c) : "v"(a), "v"(b));
    return c;
}
#ifndef REP_IDX
#define REP_IDX 1
#endif
#ifndef REP_ATT
#define REP_ATT 1
#endif
__device__ __forceinline__ f32x16 mfma32_raw(bf16x8 a, bf16x8 b, f32x16 c) { return __builtin_amdgcn_mfma_f32_32x32x16_bf16(a, b, c, 0, 0, 0); }
__device__ __forceinline__ pg8::f32x4 mfma16_f8(long a, long b, pg8::f32x4 c) {
    c = __builtin_amdgcn_mfma_f32_16x16x32_fp8_fp8(a, b, c, 0, 0, 0);
    asm volatile("s_nop 3" : "+v"(c) : "v"(a), "v"(b));
    return c;
}
constexpr int DSA_QB = 32;
constexpr int DSA_SEL = 0, DSA_SMALL = 16384, DSA_HIST = 17408, DSA_VBUF = 17408, DSA_VROW = 144, DSA_TMOFF = 256 * 33, DSA_OBUF = 98304;
__device__ __forceinline__ float relu1(float x) { return __builtin_amdgcn_fmed3f(x, 0.f, 3.0e38f); }
__device__ __forceinline__ unsigned lds_add(LAS unsigned* p, unsigned v) { return __hip_atomic_fetch_add(p, v, __ATOMIC_RELAXED, __HIP_MEMORY_SCOPE_WORKGROUP); }
__device__ __forceinline__ unsigned q20key(float sc) {
    const unsigned u = __builtin_bit_cast(unsigned, sc);
    int v = (int)((u & 0x7fffffffu) >> 9) - (107 << 14);
    v = v < 0 ? 0 : (v > 0x7ffff ? 0x7ffff : v);
    const unsigned s = (unsigned)((int)u >> 31);
    return (unsigned)v ^ (0x80000u ^ (s & 0xfffffu));
}
__device__ __forceinline__ void hist_select(const LAS unsigned* hrow, unsigned need, int lane, unsigned& bin_out, unsigned& above_out, int nl = 64) {
    const pg8::u32x4 a = *(const LAS pg8::u32x4*)(hrow + 8 * lane), b = *(const LAS pg8::u32x4*)(hrow + 8 * lane + 4);
    unsigned c[8] = {a[0], a[1], a[2], a[3], b[0], b[1], b[2], b[3]};
    unsigned tot = 0;
#pragma unroll
    for (int j = 0; j < 8; ++j) tot += c[j];
    if (lane >= nl) tot = 0;
    unsigned incl = tot;
#pragma unroll
    for (int d = 1; d < 64; d <<= 1) { const unsigned y = shfrom(incl, lane + d); incl += (lane + d < 64) ? y : 0u; }
    const unsigned excl = incl - tot;
    unsigned bin = 0, above = 0; const bool mine = excl < need && need <= incl;
    if (mine) {
        unsigned acc = excl; bool done = false;
#pragma unroll
        for (int j = 7; j >= 0; --j) { if (!done && acc + c[j] >= need) { bin = 8 * lane + j; above = acc; done = true; } if (!done) acc += c[j]; }
    }
    const unsigned long long bal = __ballot(mine);
    const int src = bal ? (int)__builtin_ctzll(bal) : 0;
    bin_out = shfrom(bin, src); above_out = shfrom(above, src);
}
__device__ __forceinline__ unsigned lin_key(float sc, float cscale) { return (unsigned)__builtin_amdgcn_fmed3f(fmaf(sc, cscale, 32768.5f), 0.f, 65535.f); }
template <int PASS>
__device__ __forceinline__ void dsa_pass(LAS unsigned char* lds, cgbf* KI, cgbf* QI, GAS v4u* keys, size_t tokb, int qb, int wave, int lane_in, pg8::f32x4 w4, float cscale_unused, unsigned ref) {
    float cscale = cscale_unused;
    const int lane = my_lane_volatile(); (void)lane_in;
    LAS unsigned* HIST = (LAS unsigned*)(lds + DSA_HIST); LAS unsigned* BMP = (LAS unsigned*)(lds + DSA_HIST);
    LAS unsigned* SM = (LAS unsigned*)(lds + DSA_SMALL);
    const int rr = lane & 31, hh = lane >> 5;
    LAS unsigned* hrow = HIST + rr * 512;
    if (PASS == 0) {
        bf16x8 qf[4][4];
#pragma unroll
        for (int h = 0; h < 4; ++h)
#pragma unroll
            for (int s = 0; s < 4; ++s) qf[h][s] = __builtin_bit_cast(bf16x8, *(cgv4u*)(QI + (tokb + 32 * qb + rr) * 256 + h * 64 + 16 * s + 8 * hh));
        bf16x8 kf[4];
        int kt = wave;
#pragma unroll
        for (int s = 0; s < 4; ++s) kf[s] = __builtin_bit_cast(bf16x8, *(cgv4u*)(KI + (tokb + 32 * kt + rr) * 64 + 16 * s + 8 * hh));
        { float rng = 0.f;
#pragma unroll
          for (int h = 0; h < 4; ++h) { float ss = 0.f;
#pragma unroll
              for (int s = 0; s < 4; ++s)
#pragma unroll
                  for (int e = 0; e < 8; ++e) { const float x = bf2f((unsigned short)qf[h][s][e]); ss += x * x; }
              ss += shx(ss, 32, lane);
              rng += fabsf(w4[h]) * sqrtf(ss); }
          cscale = 32768.0f / fmaxf(12.0f * rng, 1e-20f); }
        for (; kt <= qb; kt += 8) {
            bf16x8 kn[4];
            const int ktn = (kt + 8 <= qb) ? kt + 8 : kt;
#pragma unroll
            for (int s = 0; s < 4; ++s) kn[s] = __builtin_bit_cast(bf16x8, *(cgv4u*)(KI + (tokb + 32 * ktn + rr) * 64 + 16 * s + 8 * hh));
            f32x16 sc;
#pragma unroll
            for (int i = 0; i < 16; ++i) sc[i] = 0.f;
#pragma unroll
            for (int hp = 0; hp < 2; ++hp) {
                f32x16 a0, a1;
#pragma unroll
                for (int i = 0; i < 16; ++i) { a0[i] = 0.f; a1[i] = 0.f; }
#pragma unroll
                for (int s = 0; s < 4; ++s) { a0 = mfma32_raw(kf[s], qf[2 * hp][s], a0); a1 = mfma32_raw(kf[s], qf[2 * hp + 1][s], a1); }
#pragma unroll
                for (int i = 0; i < 16; ++i) sc[i] = fmaf(w4[2 * hp + 1], relu1(a1[i]), fmaf(w4[2 * hp], relu1(a0[i]), sc[i]));
            }
            asm volatile("s_nop 3" :: "v"(kf[0]), "v"(kf[1]), "v"(kf[2]), "v"(kf[3]));
            unsigned kw[8];
            if (kt != qb) {
#pragma unroll
                for (int i = 0; i < 16; ++i) { const unsigned k16 = lin_key(sc[i], cscale);
                    lds_add(hrow + (k16 >> 7), 1u);
                    if (i & 1) kw[i >> 1] |= k16 << 16; else kw[i >> 1] = k16; }
            } else {
#pragma unroll
                for (int i = 0; i < 16; ++i) { const bool v = ((i & 3) + 8 * (i >> 2) + 4 * hh) <= rr; const unsigned k16 = v ? lin_key(sc[i], cscale) : 0u;
                    lds_add(hrow + (k16 >> 7), v ? 1u : 0u);
                    if (i & 1) kw[i >> 1] |= k16 << 16; else kw[i >> 1] = k16; }
            }
            keys[(size_t)(kt * 64 + lane) * 2] = (v4u){kw[0], kw[1], kw[2], kw[3]};
            keys[(size_t)(kt * 64 + lane) * 2 + 1] = (v4u){kw[4], kw[5], kw[6], kw[7]};
#pragma unroll
            for (int s = 0; s < 4; ++s) kf[s] = kn[s];
        }
    } else {
        for (int kt = wave; kt <= qb; kt += 8) {
            const v4u ka = keys[(size_t)(kt * 64 + lane) * 2], kb = keys[(size_t)(kt * 64 + lane) * 2 + 1];
            unsigned kw[8] = {ka[0], ka[1], ka[2], ka[3], kb[0], kb[1], kb[2], kb[3]};
            if (PASS == 1) {
#pragma unroll
                for (int i = 0; i < 16; ++i) { const unsigned k16 = (i & 1) ? (kw[i >> 1] >> 16) : (kw[i >> 1] & 0xffffu);
                    lds_add(hrow + (k16 & 127u), (k16 >> 7) == ref ? 1u : 0u); }
            } else {
                unsigned mg = 0u, me = 0u;
#pragma unroll
                for (int i = 0; i < 16; ++i) { const unsigned k16 = (i & 1) ? (kw[i >> 1] >> 16) : (kw[i >> 1] & 0xffffu); const unsigned bit = 1u << ((i & 3) + 8 * (i >> 2));
                    mg |= k16 > ref ? bit : 0u; me |= k16 == ref ? bit : 0u; }
                mg <<= 4 * hh; me <<= 4 * hh;
                mg |= shx(mg, 32, lane); me |= shx(me, 32, lane);
                if (hh == 0) { BMP[kt * 33 + rr] = mg; BMP[DSA_TMOFF + kt * 33 + rr] = me; }
            }
        }
    }
}
__device__ __forceinline__ void dsa_unit(unsigned char* ws, GAS v4u* keys, LAS unsigned char* lds, int b, int qb, int tid_in, int wave, int lane_in) {
    int lane = my_lane_volatile(), tid = (wave << 6) | lane; (void)lane_in; (void)tid_in;
    cgbf* QI = (cgbf*)(ws + WS_QI); cgbf* KI = (cgbf*)(ws + WS_KI); cgf32* GT = (cgf32*)(ws + WS_GT);
    cgbf* Qa = (cgbf*)(ws + WS_Q); cgbf* KV = (cgbf*)(ws + WS_KV); gbf* MIX = (gbf*)(ws + WS_MIX);
    LAS unsigned* HIST = (LAS unsigned*)(lds + DSA_HIST); LAS unsigned short* SEL = (LAS unsigned short*)(lds + DSA_SEL);
    LAS unsigned* SM = (LAS unsigned*)(lds + DSA_SMALL);
    const int rr = lane & 31, hh = lane >> 5;
    const unsigned Z = opaque0();
    const int t0 = DSA_QB * qb; const size_t tokb = (size_t)b * S;
    for (int rep_i = 0; rep_i < REP_IDX; ++rep_i) {
    if (qb >= 8) {
        const pg8::f32x4 w4 = *(cgf32x4*)(GT + (tokb + t0 + rr) * 16);
        const float cscale = 0.f;
        unsigned my_bstar = 0, my_thr = 0;
        for (int pass = 0; pass < 3; ++pass) {
            if (pass < 2) {
#pragma unroll
                for (int i = 0; i < 8; ++i) *(LAS pg8::u32x4*)(lds + DSA_HIST + (tid + 512 * i) * 16) = (pg8::u32x4){Z, Z, Z, Z};
            }
            __syncthreads();
            if (pass == 0) dsa_pass<0>(lds, KI, QI, keys, tokb, qb, wave, lane, w4, cscale, 0u);
            else if (pass == 1) dsa_pass<1>(lds, KI, QI, keys, tokb, qb, wave, lane, w4, cscale, my_bstar);
            else dsa_pass<2>(lds, KI, QI, keys, tokb, qb, wave, lane, w4, cscale, my_thr);
            __syncthreads();
            if (pass == 0) {
#pragma unroll
                for (int j = 0; j < 4; ++j) { const int row = 4 * wave + j; unsigned bin, above; hist_select(HIST + row * 512, 256u, lane, bin, above); if (lane == 0) { SM[row] = bin; SM[32 + row] = above; } }
            } else if (pass == 1) {
#pragma unroll
                for (int j = 0; j < 4; ++j) { const int row = 4 * wave + j; const unsigned ab1 = SM[32 + row]; unsigned sb, above; hist_select(HIST + row * 512, 256u - ab1, lane, sb, above, 16);
                    if (lane == 0) { SM[64 + row] = (SM[row] << 7) | sb; SM[96 + row] = 256u - ab1 - above; } }
            } else {
                const LAS unsigned* BMP = (const LAS unsigned*)(lds + DSA_HIST);
                for (int j = 0; j < 4; ++j) {
                    const int row = 4 * wave + j;
                    const unsigned need = SM[96 + row];
                    unsigned bw[4], tw[4];
#pragma unroll
                    for (int e = 0; e < 4; ++e) { const int wi = lane + 64 * e; const bool ok = wi <= qb; bw[e] = ok ? BMP[wi * 33 + row] : 0u; tw[e] = ok ? BMP[DSA_TMOFF + wi * 33 + row] : 0u; }
                    unsigned m = (unsigned)(__builtin_popcount(tw[0]) + __builtin_popcount(tw[1]) + __builtin_popcount(tw[2]) + __builtin_popcount(tw[3]));
#pragma unroll
                    for (int o = 1; o < 64; o <<= 1) m += shx(m, o, lane);
                    if (m > need) {
                        unsigned lo = 0, hi = 8191;
                        while (lo < hi) { const unsigned mid = (lo + hi) >> 1; unsigned c = 0;
#pragma unroll
                            for (int e = 0; e < 4; ++e) { const int nb = (int)mid + 1 - 32 * (lane + 64 * e); const unsigned km = nb >= 32 ? 0xffffffffu : (nb <= 0 ? 0u : ((1u << nb) - 1u)); c += (unsigned)__builtin_popcount(tw[e] & km); }
#pragma unroll
                            for (int o = 1; o < 64; o <<= 1) c += shx(c, o, lane);
                            if (c >= need) hi = mid; else lo = mid + 1; }
#pragma unroll
                        for (int e = 0; e < 4; ++e) { const int nb = (int)lo + 1 - 32 * (lane + 64 * e); const unsigned km = nb >= 32 ? 0xffffffffu : (nb <= 0 ? 0u : ((1u << nb) - 1u)); tw[e] &= km; }
                    }
                    unsigned cnt = 0;
#pragma unroll
                    for (int e = 0; e < 4; ++e) { bw[e] |= tw[e]; cnt += (unsigned)__builtin_popcount(bw[e]); }
                    unsigned incl = cnt;
#pragma unroll
                    for (int d = 1; d < 64; d <<= 1) { const unsigned y = shfrom(incl, lane - d); incl += (lane >= d) ? y : 0u; }
                    unsigned pos = incl - cnt;
#pragma unroll
                    for (int e = 0; e < 4; ++e) { unsigned w = bw[e]; const unsigned kb = 32u * (unsigned)(lane + 64 * e);
                        while (w) { const unsigned bit = (unsigned)__builtin_ctz(w); if (pos < 256u) SEL[row * 256 + pos] = (unsigned short)(kb + bit); ++pos; w &= w - 1u; } }
                }
            }
            __syncthreads();
            if (pass == 0) my_bstar = SM[rr]; else if (pass == 1) my_thr = SM[64 + rr];
        }
    } else {
        for (int i = tid; i < DSA_QB * 256; i += NTHR) SEL[i] = (unsigned short)(i & 255);
        __syncthreads();
    }
    }
    lane = my_lane_volatile();
    const int c = lane & 15, kg = lane >> 4, q4 = (lane >> 2) & 3, p4 = lane & 3;
    LAS unsigned char* vb = lds + DSA_VBUF + wave * (2 * 32 * DSA_VROW);
    const GAS unsigned char* KVb = (const GAS unsigned char*)KV + tokb * 128;
    for (int rep_a = 0; rep_a < REP_ATT; ++rep_a)
    for (int qq = 0; qq < 4; ++qq) {
        const int r = 4 * wave + qq, t = t0 + r; const int cnt = t + 1 < 256 ? t + 1 : 256;
        const LAS unsigned short* sel = SEL + r * 256;
        long qa[2];
#pragma unroll
        for (int s = 0; s < 2; ++s) { const pg8::u32x2 x = *(const GAS pg8::u32x2*)((const GAS unsigned char*)Qa + (tokb + t) * 512 + (c & 7) * 64 + 16 * kg + 8 * s);
            qa[s] = c >= 8 ? (long)(unsigned long long)Z : (long)(((unsigned long long)x[1] << 32) | x[0]); }
        float lg[8][2][4];
        {
            v4u kfr[8][2];
#pragma unroll
            for (int ch = 0; ch < 8; ++ch)
#pragma unroll
                for (int ab = 0; ab < 2; ++ab) { const int slot = 32 * ch + 16 * ab + c; const unsigned idx = slot < cnt ? (unsigned)sel[slot] : 0u;
                    kfr[ch][ab] = *(cgv4u*)(KVb + (idx * 128u + 16u * kg)); }
#pragma unroll
            for (int ch = 0; ch < 8; ++ch)
#pragma unroll
                for (int ab = 0; ab < 2; ++ab) { pg8::f32x4 acc = {0.f, 0.f, 0.f, 0.f};
                    acc = mfma16_f8((long)(((unsigned long long)kfr[ch][ab][1] << 32) | kfr[ch][ab][0]), qa[0], acc);
                    acc = mfma16_f8((long)(((unsigned long long)kfr[ch][ab][3] << 32) | kfr[ch][ab][2]), qa[1], acc);
#pragma unroll
                    for (int e = 0; e < 4; ++e) lg[ch][ab][e] = acc[e]; }
        }
        if (cnt < 256) {
#pragma unroll
            for (int ch = 0; ch < 8; ++ch)
#pragma unroll
                for (int ab = 0; ab < 2; ++ab)
#pragma unroll
                    for (int e = 0; e < 4; ++e) if (32 * ch + 16 * ab + 4 * kg + e >= cnt) lg[ch][ab][e] = -INFINITY;
        }
        v4u vr[4][2][2];
#pragma unroll
        for (int bt = 0; bt < 4; ++bt)
#pragma unroll
            for (int cc = 0; cc < 2; ++cc)
#pragma unroll
                for (int i = 0; i < 2; ++i) { const int j = (lane >> 2) + 16 * i, slot = 32 * (2 * bt + cc) + j; const unsigned idx = slot < cnt ? (unsigned)sel[slot] : 0u;
                    vr[bt][cc][i] = *(cgv4u*)(KVb + (idx * 128u + 64u + 16u * (lane & 3))); }
        float mx = -INFINITY;
#pragma unroll
        for (int ch = 0; ch < 8; ++ch)
#pragma unroll
            for (int ab = 0; ab < 2; ++ab)
#pragma unroll
                for (int e = 0; e < 4; ++e) mx = fmaxf(mx, lg[ch][ab][e]);
        mx = fmaxf(mx, shx(mx, 16, lane)); mx = fmaxf(mx, shx(mx, 32, lane));
        const float C8 = 0.18033688011112042f, mxc = mx * C8;
        float sum = 0.f;
#pragma unroll
        for (int ch = 0; ch < 8; ++ch)
#pragma unroll
            for (int ab = 0; ab < 2; ++ab)
#pragma unroll
                for (int e = 0; e < 4; ++e) { const float pe = __builtin_amdgcn_exp2f(fmaf(lg[ch][ab][e], C8, -mxc)); lg[ch][ab][e] = pe; sum += pe; }
        sum += shx(sum, 16, lane); sum += shx(sum, 32, lane);
        const float isum = 1.0f / sum;
        pg8::f32x4 o[4];
#pragma unroll
        for (int nt = 0; nt < 4; ++nt) o[nt] = (pg8::f32x4){0.f, 0.f, 0.f, 0.f};
#pragma unroll
        for (int bt = 0; bt < 4; ++bt) {
#pragma unroll
            for (int cc = 0; cc < 2; ++cc)
#pragma unroll
                for (int i = 0; i < 2; ++i) { const int j = (lane >> 2) + 16 * i; const v4u x = vr[bt][cc][i]; v4u w0, w1;
#pragma unroll
                    for (int e = 0; e < 4; ++e) { const pg8::f32x2 f0 = __builtin_amdgcn_cvt_pk_f32_fp8((int)x[e], false), f1 = __builtin_amdgcn_cvt_pk_f32_fp8((int)x[e], true);
                        const unsigned a = pk2(f0[0], f0[1]), b = pk2(f1[0], f1[1]);
                        if (e < 2) { w0[2 * e] = a; w0[2 * e + 1] = b; } else { w1[2 * (e - 2)] = a; w1[2 * (e - 2) + 1] = b; } }
                    LAS unsigned char* d = vb + (32 * cc + j) * DSA_VROW + 32 * (lane & 3);
                    *(LAS v4u*)(d) = w0; *(LAS v4u*)(d + 16) = w1; }
#pragma unroll
            for (int cc = 0; cc < 2; ++cc) { const int ch = 2 * bt + cc;
                pg8::u32x4 a2w;
                a2w[0] = pg8::cvt_pk_bf16(lg[ch][0][0] * isum, lg[ch][0][1] * isum); a2w[1] = pg8::cvt_pk_bf16(lg[ch][0][2] * isum, lg[ch][0][3] * isum);
                a2w[2] = pg8::cvt_pk_bf16(lg[ch][1][0] * isum, lg[ch][1][1] * isum); a2w[3] = pg8::cvt_pk_bf16(lg[ch][1][2] * isum, lg[ch][1][3] * isum);
                const bf16x8 a2 = __builtin_bit_cast(bf16x8, a2w);
#pragma unroll
                for (int nt = 0; nt < 4; ++nt) { const LAS unsigned char* a = vb + (32 * cc + 4 * kg + q4) * DSA_VROW + 32 * nt + 8 * p4; o[nt] = mfma16(a2, cat8(tr16(a), tr16(a + 16 * DSA_VROW)), o[nt]); }
            }
        }
        if (kg < 2) {
            LAS unsigned short* ob = (LAS unsigned short*)(lds + DSA_OBUF + wave * 4096 + qq * 1024);
#pragma unroll
            for (int nt = 0; nt < 4; ++nt)
#pragma unroll
                for (int e = 0; e < 4; ++e) ob[(4 * kg + e) * 64 + 16 * nt + c] = (unsigned short)f2bf(o[nt][e]);
        }
    }
    LDS_WAIT();
#pragma unroll
    for (int qq = 0; qq < 4; ++qq) {
        const v4u x = *(const LAS v4u*)(lds + DSA_OBUF + wave * 4096 + qq * 1024 + lane * 16);
        *(GAS v4u*)(MIX + (tokb + t0 + 4 * wave + qq) * 1024 + lane * 8) = x;
    }
    __syncthreads();
}
__device__ __forceinline__ void dsa_phase(unsigned char* ws, unsigned char* keyscr, LAS unsigned char* lds, int G, int bx, int tid, int wave, int lane) {
    GAS v4u* keys = (GAS v4u*)(keyscr + (size_t)(bx & 255) * (MiB / 2));
#pragma unroll 1
    for (int u = bx; u < NB * 256; u += G) { const int i = (u >> 2) & 63, k = u >> 8; const int qb = (k == 0) ? 255 - i : (k == 1) ? 128 + i : (k == 2) ? 127 - i : i; dsa_unit(ws, keys, lds, u & 3, qb, tid, wave, lane); }
}
#ifndef REP_UP
#define REP_UP 1
#endif
#ifndef REP_INP
#define REP_INP 1
#endif
constexpr int PH_PER_LAYER = 9, NPHASE = 1 + DEPTH * PH_PER_LAYER;
__global__ void __launch_bounds__(NTHR, 2) mega_fwd(Params P) {
    extern __shared__ __attribute__((aligned(16))) unsigned char lds_raw[];
    LAS unsigned char* lds = (LAS unsigned char*)lds_raw;
    volatile LAS unsigned* MISC = (volatile LAS unsigned*)(lds + MISC_OFF);
    const int wave = __builtin_amdgcn_readfirstlane(threadIdx.x >> 6);
#define MYLANE() my_lane_volatile()
#define MYTID() ((wave << 6) | MYLANE())
    const int tid = MYTID(), lane = tid & 63;
    const int G = gridDim.x;
    gu32* ctl = (gu32*)(P.ws + WS_CTL);
    for (int u = tid; u < (LDS_BYTES - LDSCTL_OFF) / 4; u += NTHR) ((LAS unsigned*)(lds + LDSCTL_OFF))[u] = 0u;
    __syncthreads();
    XcdBarrier bar = xcd_barrier_post((unsigned*)(ctl + CW_BAR) + P.li * XCD_BAR_WORDS, MISC + 8, wave);
#if HYB
    const int lo = P.ph_lo, hi = P.ph_hi;
#endif
#if HYB
#define IN(k) (lo <= (k) && (k) < hi)
#define SEAM(k) do { if (IN(k) && IN((k) + 1)) xcd_barrier(bar); } while (0)
#else
#define IN(k) (true)
#define SEAM(k) do { xcd_barrier(bar); } while (0)
#endif

#ifndef REP_P0
#define REP_P0 1
#endif
    for (int rep0 = 0; rep0 < REP_P0; ++rep0)
    if (IN(0)) { const int bx0 = blockIdx.x; const int vcu = (G % 8 == 0) ? (bx0 % 8) * (G / 8) + bx0 / 8 : bx0; p0_prologue(P, lds, vcu, G, wave, lane); }
    SEAM(0);

    for (int l = 0; l < DEPTH; ++l) {
        const int pb = 1 + l * PH_PER_LAYER;
        for (int f = 0; f < 2; ++f) {
            int bx = (int)blockIdx.x; asm volatile("" : "+s"(bx));
            unsigned char* ws = P.ws; asm volatile("" : "+s"(ws));
            float* X = P.out; asm volatile("" : "+s"(X));
            bf16_t* XB = (bf16_t*)(ws + WS_XB); float* SS = (float*)(ws + WS_SS); bf16_t* ACT = (bf16_t*)(ws + WS_ACT);
            unsigned char* wl = ws + WS_W + (size_t)l * W_LAYER;
            if (f == 1) {
                for (int rep_n = 0; rep_n < REP_INP; ++rep_n)
                if (IN(pb + 2)) {
                    pg8::Gemm g{XB, (const bf16_t*)(wl + WO_IN), T, INP, D}; pg8::StaticOrder So; So.init(T, INP, G, bx);
                    pg8::EpiIn E{(pg8::cgf32*)SS, (pg8::cgf32*)(ws + WS_CS), (pg8::cgf32*)(P.in[I_QN] + l * 64), (pg8::cgf32*)(P.in[I_KN] + l * 64), (pg8::cgf32*)(P.in[I_GB] + l * 8),
                                 (pg8::gbf16*)(ws + WS_Q), (pg8::gbf16*)(ws + WS_KV), (pg8::gbf16*)(ws + WS_QI), (pg8::gbf16*)(ws + WS_KI), (pg8::gbf16*)(ws + WS_QKM), (pg8::gbf16*)(ws + WS_VM), (pg8::gbf16*)(ws + WS_OM), (pg8::gf32*)(ws + WS_GT)};
                    pg8::gemm_phase<pg8::EpiIn, pg8::StaticOrder, true, true>(lds, g, So, E, MYTID());
                }
                SEAM(pb + 2);
                if (IN(pb + 3)) { MIXER_M1 }
                SEAM(pb + 3);
                if (IN(pb + 4)) { MIXER_M2_DSA }
                SEAM(pb + 4);
                if (IN(pb + 5)) { MIXER_M3 }
                SEAM(pb + 5);
                if (IN(pb + 6)) {
                    pg8::Gemm g{(const bf16_t*)(ws + WS_MIX), (const bf16_t*)(wl + WO_OUT), T, D, D}; pg8::StaticOrder So; So.init(T, D, G, bx);
                    if (FP8UPLAST && l == DEPTH - 1) { pg8::EpiRes<false, true> E{(pg8::gf32*)X, (pg8::gbf16*)XB, (pg8::gf32*)SS, (PG8_GAS unsigned char*)(ws + WS_XB8), 1.0f};
                        pg8::gemm_phase<pg8::EpiRes<false, true>, pg8::StaticOrder, true, true>(lds, g, So, E, MYTID()); }
                    else { pg8::EpiRes<false> E{(pg8::gf32*)X, (pg8::gbf16*)XB, (pg8::gf32*)SS, (PG8_GAS unsigned char*)nullptr, 1.0f};
                        pg8::gemm_phase<pg8::EpiRes<false>, pg8::StaticOrder, true, true>(lds, g, So, E, MYTID()); }
                }
                SEAM(pb + 6);
            }
            const int pu = pb + (f ? 7 : 0);
            for (int rep_u = 0; rep_u < REP_UP; ++rep_u)
            if (IN(pu)) {
                pg8::StaticOrder So; So.init(T, 2 * DFF, G, bx);
                if (FP8UPLAST && l == DEPTH - 1 && (f == 1 || FP8UPLAST >= 2)) {
                    pg8::Gemm g{(const bf16_t*)(ws + WS_XB8), (const bf16_t*)(wl + (f ? WO_U2 : WO_U1)), T, 2 * DFF, D / 2};
                    pg8::EpiUp E{(PG8_GAS unsigned char*)ACT, (pg8::cgf32*)SS, 1.0f / pg8::WUP_SCALE};
                    pg8::gemm_phase<pg8::EpiUp, pg8::StaticOrder, true, true, true>(lds, g, So, E, MYTID());
                } else {
                    pg8::Gemm g{XB, (const bf16_t*)(wl + (f ? WO_U2 : WO_U1)), T, 2 * DFF, D};
                    pg8::EpiUp E{(PG8_GAS unsigned char*)ACT, (pg8::cgf32*)SS, 1.0f};
                    pg8::gemm_phase<pg8::EpiUp, pg8::StaticOrder, true, true>(lds, g, So, E, MYTID());
                }
            }
            SEAM(pu);
            if (IN(pu + 1)) {
                constexpr float a_dn = FP8DOWN ? 0.5f / (pg8::ACT_SCALE * pg8::WDN_SCALE) : 0.5f;
                pg8::Gemm g{ACT, (const bf16_t*)(wl + (f ? WO_D2 : WO_D1)), T, D, FP8DOWN ? DFF / 2 : DFF}; pg8::StaticOrder So; So.init(T, D, G, bx);
                if (l == DEPTH - 1 && f == 1) { pg8::EpiRes<true> E{(pg8::gf32*)X, (pg8::gbf16*)XB, (pg8::gf32*)SS, (PG8_GAS unsigned char*)nullptr, a_dn}; pg8::gemm_phase<pg8::EpiRes<true>, pg8::StaticOrder, true, true, FP8DOWN != 0>(lds, g, So, E, MYTID()); }
                else if (FP8UPLAST >= 2 && l == DEPTH - 2 && f == 1) { pg8::EpiRes<false, true> E{(pg8::gf32*)X, (pg8::gbf16*)XB, (pg8::gf32*)SS, (PG8_GAS unsigned char*)(ws + WS_XB8), a_dn}; pg8::gemm_phase<pg8::EpiRes<false, true>, pg8::StaticOrder, true, true, FP8DOWN != 0>(lds, g, So, E, MYTID()); }
                else { pg8::EpiRes<false> E{(pg8::gf32*)X, (pg8::gbf16*)XB, (pg8::gf32*)SS, (PG8_GAS unsigned char*)nullptr, a_dn}; pg8::gemm_phase<pg8::EpiRes<false>, pg8::StaticOrder, true, true, FP8DOWN != 0>(lds, g, So, E, MYTID()); }
            }
            if (!(l == DEPTH - 1 && f == 1)) SEAM(pu + 1);
        }
    }
#undef IN
#undef SEAM
}
extern "C" void kernel_launch(void* const* d_in, const int* in_sizes, int n_in, void* d_out, int out_size, void* d_ws, size_t ws_size, hipStream_t stream) {
    static int grid = 0;
    if (grid == 0) {
        if (n_in != 18 || out_size != T * D || ws_size < WS_END) { fprintf(stderr, "kernel_launch: unexpected sizes (n_in %d out %d ws %zu)\n", n_in, out_size, ws_size); grid = -1; return; }
        int dev = 0, cus = 0, per_cu = 0;
        if (hipGetDevice(&dev) != hipSuccess || hipDeviceGetAttribute(&cus, hipDeviceAttributeMultiprocessorCount, dev) != hipSuccess) { grid = -1; return; }
        if (hipFuncSetAttribute((const void*)mega_fwd, hipFuncAttributeMaxDynamicSharedMemorySize, LDS_BYTES) != hipSuccess) { fprintf(stderr, "kernel_launch: hipFuncSetAttribute failed\n"); grid = -1; return; }
        if (hipOccupancyMaxActiveBlocksPerMultiprocessor(&per_cu, (const void*)mega_fwd, NTHR, LDS_BYTES) != hipSuccess || per_cu < 1)
            fprintf(stderr, "kernel_launch: note: occupancy query reports %d workgroups per CU\n", per_cu);
        (void)hipGetLastError();
        grid = cus > 256 ? 256 : cus;
    }
    if (grid < 0) return;
    if (hipMemsetAsync((char*)d_ws + WS_CTL, 0, CTL_ZERO_BYTES, stream) != hipSuccess) return;
    Params p{};
    for (int i = 0; i < 18; ++i) p.in[i] = (const float*)d_in[i];
    p.out = (float*)d_out; p.ws = (unsigned char*)d_ws; p.ph_lo = 0; p.ph_hi = NPHASE; p.li = 0; p.flags = 0;
    hipLaunchKernelGGL(mega_fwd, dim3(grid), dim3(NTHR), LDS_BYTES, stream, p);
    const hipError_t le = hipPeekAtLastError();
    if (le != hipSuccess) fprintf(stderr, "kernel_launch: launch failed: %s\n", hipGetErrorName(le));
}
```

```cpp
#include <hip/hip_runtime.h>
#include <stdint.h>
#include <math.h>
#include <cstdio>

constexpr int D = 1024, NB = 4, S = 8192, DEPTH = 2, T = NB * S;
constexpr int TOPK = 256, DFF = 2816, INC = 3020, INP = 3072;
constexpr float EPS = 1e-6f;
constexpr int C_Q = 0, C_K = 512, C_V = 576, C_QI = 640, C_KI = 896, C_WI = 960, C_QKM = 964, C_VM = 1988, C_OM = 2500, C_IG = 3012, C_FG = 3016;
typedef unsigned short bf16_t;


__device__ __forceinline__ int shx_i(int v, int m, int lane) { return __builtin_amdgcn_ds_bpermute((lane ^ m) << 2, v); }
__device__ __forceinline__ float shx(float v, int m, int lane) { return __builtin_bit_cast(float, shx_i(__builtin_bit_cast(int, v), m, lane)); }
__device__ __forceinline__ unsigned shx(unsigned v, int m, int lane) { return (unsigned)shx_i((int)v, m, lane); }
__device__ __forceinline__ float shfrom(float v, int src) { return __builtin_bit_cast(float, __builtin_amdgcn_ds_bpermute(src << 2, __builtin_bit_cast(int, v))); }
__device__ __forceinline__ unsigned shfrom(unsigned v, int src) { return (unsigned)__builtin_amdgcn_ds_bpermute(src << 2, (int)v); }
#ifndef FP8DOWN
#define FP8DOWN 1
#endif
#ifndef FP8UPLAST
#define FP8UPLAST 3
#endif
#define HYB 0
namespace pg8 {
#define PG8_LAS __attribute__((address_space(3)))
typedef unsigned short bf16_t;
typedef short bf16x8 __attribute__((ext_vector_type(8)));
typedef float f32x4 __attribute__((ext_vector_type(4)));
typedef unsigned u32x4 __attribute__((ext_vector_type(4)));
typedef int i32x4 __attribute__((ext_vector_type(4)));
constexpr int BM = 256, BK = 64, HALF = 128, HTB = HALF * BK * 2  , STAGE_BYTES = 8 * HTB, NXCD = 8, WGM = 8;

__host__ __device__ __forceinline__ int lds_byte(int r, int c) { const int st = (r >> 4) * 2 + (c >> 5), rr = r & 15, cc = c & 31, ob = rr * 64 + cc * 2; return st * 1024 + (ob ^ (((ob >> 9) & 1) << 5)); }
__host__ __device__ __forceinline__ void stage_rc(int b, int& R, int& C) { const int st = b / 1024, sb = b % 1024, swz = sb ^ (((sb >> 9) & 1) << 5); R = (st >> 1) * 16 + swz / 64; C = (st & 1) * 32 + (swz % 64) / 2; }
__host__ __device__ __forceinline__ int perm32(int rho) { const int n = rho >> 4, i = rho & 15; return 8 * (i >> 2) + 4 * n + (i & 3); }

struct Unit { int pm, pn; };
struct Gemm { const bf16_t* A; const bf16_t* Bt; int M, N, K; };

struct StaticOrder {
    int nM, nN, nwg, G, c;
    __host__ __device__ void init(int M, int N, int G_, int c_) { nM = M / BM; nN = N / BM; nwg = nM * nN; G = G_; c = c_; }
    __host__ __device__ bool next(int i, Unit& u) const {
        const long L = (long)i * G + c; if (L >= nwg) return false;
        int wgid = (int)L; { const int q = nwg / NXCD, r = nwg % NXCD, xcd = wgid % NXCD, off = wgid / NXCD; wgid = (xcd < r ? xcd * (q + 1) : r * (q + 1) + (xcd - r) * q) + off; }
        const int nig = WGM * nN, gid = wgid / nig, fm = gid * WGM, gsz = (nM - fm) < WGM ? (nM - fm) : WGM;
        u.pm = fm + ((wgid % nig) % gsz); u.pn = (wgid % nig) / gsz; return true;
    }
    __device__ __forceinline__ void a_ready(const Unit&) const {}
    __device__ __forceinline__ void done(const Unit&) const {}
};

__device__ __forceinline__ unsigned cvt_pk_bf16(float lo, float hi) { unsigned r; asm volatile("v_cvt_pk_bf16_f32 %0, %1, %2" : "=v"(r) : "v"(lo), "v"(hi)); return r; }
typedef float f32x2 __attribute__((ext_vector_type(2)));
#define PG8_GAS __attribute__((address_space(1)))
typedef PG8_GAS float gf32; typedef PG8_GAS bf16_t gbf16; typedef PG8_GAS f32x4 gf32x4; typedef PG8_GAS u32x4 gu32x4;
typedef const PG8_GAS float cgf32; typedef const PG8_GAS f32x4 cgf32x4;
__device__ __forceinline__ u32x4 pack8(const f32x4& a, const f32x4& b) { u32x4 w; w.x = cvt_pk_bf16(a[0], a[1]); w.y = cvt_pk_bf16(a[2], a[3]); w.z = cvt_pk_bf16(b[0], b[1]); w.w = cvt_pk_bf16(b[2], b[3]); return w; }
__device__ __forceinline__ float row_rstd(cgf32* SS, int row, int fq, int lane) {
    const f32x4 p = *(cgf32x4*)(SS + (size_t)row * 16 + 4 * fq);
    float s = (p[0] + p[1]) + (p[2] + p[3]);
    s += shx(s, 16, lane); s += shx(s, 32, lane);
    return rsqrtf(s * (1.0f / 1024.0f) + EPS);
}
__device__ __forceinline__ void row_rstd8(cgf32* SS, int row0, int fq, int lane, float (&rs)[2][4]) {
    f32x4 p[2][4];
#pragma unroll
    for (int ai = 0; ai < 2; ++ai)
#pragma unroll
        for (int m = 0; m < 4; ++m) p[ai][m] = *(cgf32x4*)(SS + (size_t)(row0 + ai * HALF + m * 16) * 16 + 4 * fq);
#pragma unroll
    for (int ai = 0; ai < 2; ++ai)
#pragma unroll
        for (int m = 0; m < 4; ++m) { float s = (p[ai][m][0] + p[ai][m][1]) + (p[ai][m][2] + p[ai][m][3]); s += shx(s, 16, lane); s += shx(s, 32, lane); rs[ai][m] = rsqrtf(s * (1.0f / 1024.0f) + EPS); }
}
__device__ __forceinline__ float silu_f(float g) { return g * __builtin_amdgcn_rcpf(1.0f + __builtin_amdgcn_exp2f(-1.4426950408889634f * g)); }

typedef unsigned u32x2 __attribute__((ext_vector_type(2)));
__device__ __forceinline__ u32x2 pack8_fp8(const f32x4& a, const f32x4& b) {
    unsigned lo = 0u, hi = 0u;
    lo = __builtin_amdgcn_cvt_pk_fp8_f32(a[0], a[1], lo, false); lo = __builtin_amdgcn_cvt_pk_fp8_f32(a[2], a[3], lo, true);
    hi = __builtin_amdgcn_cvt_pk_fp8_f32(b[0], b[1], hi, false); hi = __builtin_amdgcn_cvt_pk_fp8_f32(b[2], b[3], hi, true);
    return (u32x2){lo, hi};
}
constexpr float WUP_SCALE = 32.0f;
constexpr float ACT_SCALE = 1.0f, WDN_SCALE = 64.0f;
struct EpiUp {
    static constexpr bool PERM = true, AFTER_DRAIN = false;
    PG8_GAS unsigned char* ACT; cgf32* SS; float asc;
    __device__ __forceinline__ void operator()(const f32x4 (&acc)[2][2][4][2], const Unit& u, int wr, int wc, int fr_in, int fq_in) const {
        int fr, fq; { int l; asm volatile("v_mbcnt_lo_u32_b32 %0, -1, 0\n\tv_mbcnt_hi_u32_b32 %0, -1, %0" : "=v"(l)); fr = l & 15; fq = l >> 4; } (void)fr_in; (void)fq_in;
        const int row0 = u.pm * BM + wr * 64 + fr, col0 = u.pn * 128 + wc * 32 + 8 * fq;
        float rs8[2][4]; row_rstd8(SS, row0, fq, fr | (fq << 4), rs8);
#pragma unroll
        for (int ai = 0; ai < 2; ++ai)
#pragma unroll
            for (int m = 0; m < 4; ++m) rs8[ai][m] *= asc;
#pragma unroll
        for (int ai = 0; ai < 2; ++ai)
#pragma unroll
            for (int m = 0; m < 4; ++m) {
                asm volatile("" ::: "memory");
                const int row = row0 + ai * HALF + m * 16;
                const float rs = rs8[ai][m];
                f32x4 o[2];
#pragma unroll
                for (int n = 0; n < 2; ++n)
#pragma unroll
                    for (int j = 0; j < 4; ++j) o[n][j] = silu_f(acc[ai][0][m][n][j] * rs) * (acc[ai][1][m][n][j] * rs);
#if FP8DOWN
                *(PG8_GAS u32x2*)(ACT + (size_t)row * DFF + col0) = pack8_fp8(o[0], o[1]);
#else
                *(gu32x4*)((gbf16*)ACT + (size_t)row * DFF + col0) = pack8(o[0], o[1]);
#endif
            }
    }
};
struct EpiUpCheap {
    static constexpr bool PERM = true, AFTER_DRAIN = false;
    gbf16* ACT; cgf32* SS; int ld;
    __device__ __forceinline__ void operator()(const f32x4 (&acc)[2][2][4][2], const Unit& u, int wr, int wc, int fr, int fq) const {
        const int row0 = u.pm * BM + wr * 64 + fr, col0 = u.pn * 128 + wc * 32 + 8 * fq;
#pragma unroll
        for (int ai = 0; ai < 2; ++ai)
#pragma unroll
            for (int m = 0; m < 4; ++m) *(gu32x4*)(ACT + (size_t)(row0 + ai * HALF + m * 16) * ld + col0) = pack8(acc[ai][0][m][0] + acc[ai][1][m][0], acc[ai][0][m][1] + acc[ai][1][m][1]);
    }
};
template <bool FINAL, bool X8COPY = false> struct EpiRes {
    static constexpr bool PERM = true, AFTER_DRAIN = false;
    gf32* Xout; gbf16* XB; gf32* SS; PG8_GAS unsigned char* X8; float alpha;
    __device__ __forceinline__ void operator()(const f32x4 (&acc)[2][2][4][2], const Unit& u, int wr, int wc, int fr_in, int fq_in) const {
        int fr, fq; { int l; asm volatile("v_mbcnt_lo_u32_b32 %0, -1, 0\n\tv_mbcnt_hi_u32_b32 %0, -1, %0" : "=v"(l)); fr = l & 15; fq = l >> 4; }
        const int row0 = u.pm * BM + wr * 64 + fr, col0 = u.pn * BM + wc * 32 + 8 * fq;
        u32x4 xin[2][4][2];
#pragma unroll
        for (int ai = 0; ai < 2; ++ai)
#pragma unroll
            for (int m = 0; m < 4; ++m)
#pragma unroll
                for (int bj = 0; bj < 2; ++bj) xin[ai][m][bj] = *(const PG8_GAS u32x4*)(XB + (size_t)(row0 + ai * HALF + m * 16) * D + col0 + bj * HALF);
#pragma unroll
        for (int ai = 0; ai < 2; ++ai)
#pragma unroll
            for (int m = 0; m < 4; ++m) {
                const int row = row0 + ai * HALF + m * 16; float ssq = 0.f;
#pragma unroll
                for (int bj = 0; bj < 2; ++bj) {
                    const unsigned o = (unsigned)row * D + col0 + bj * HALF;
                    const u32x4 xb = xin[ai][m][bj];
                    f32x4 x0, x1;
                    x0[0] = __builtin_bit_cast(float, xb[0] << 16); x0[1] = __builtin_bit_cast(float, xb[0] & 0xffff0000u); x0[2] = __builtin_bit_cast(float, xb[1] << 16); x0[3] = __builtin_bit_cast(float, xb[1] & 0xffff0000u);
                    x1[0] = __builtin_bit_cast(float, xb[2] << 16); x1[1] = __builtin_bit_cast(float, xb[2] & 0xffff0000u); x1[2] = __builtin_bit_cast(float, xb[3] << 16); x1[3] = __builtin_bit_cast(float, xb[3] & 0xffff0000u);
                    const f32x4 y0 = x0 + alpha * acc[ai][bj][m][0], y1 = x1 + alpha * acc[ai][bj][m][1];
                    if (FINAL) { *(gf32x4*)(Xout + o) = y0; *(gf32x4*)(Xout + o + 4) = y1; }
                    else {
                        *(gu32x4*)(XB + o) = pack8(y0, y1);
                        if constexpr (X8COPY) *(PG8_GAS u32x2*)(X8 + o) = pack8_fp8(y0, y1);
                        ssq += (y0[0] * y0[0] + y0[1] * y0[1]) + (y0[2] * y0[2] + y0[3] * y0[3]) + (y1[0] * y1[0] + y1[1] * y1[1]) + (y1[2] * y1[2] + y1[3] * y1[3]);
                    }
                }
                if (!FINAL) { ssq += shx(ssq, 16, fr | (fq << 4)); ssq += shx(ssq, 32, fr | (fq << 4)); if (fq == 0) SS[(size_t)row * 16 + u.pn * 4 + wc] = ssq; }
            }
    }
};
struct EpiIn {
    static constexpr bool PERM = true, AFTER_DRAIN = false;
    cgf32* SS; cgf32* cs; cgf32* qn; cgf32* kn; cgf32* gate_b;
    gbf16 *Q, *KV, *QI, *KI, *QKM, *VM, *OM; gf32* GT;
    __device__ __forceinline__ void operator()(const f32x4 (&acc)[2][2][4][2], const Unit& u, int wr, int wc, int fr_in, int fq_in) const {
        const int fr = fr_in, fq = fq_in;
        const int row0 = u.pm * BM + wr * 64 + fr;
        float rs8[2][4]; row_rstd8(SS, row0, fq, fr | (fq << 4), rs8);
#pragma unroll
        for (int ai = 0; ai < 2; ++ai)
#pragma unroll
            for (int m = 0; m < 4; ++m) {
                asm volatile("" ::: "memory");
                const int row = row0 + ai * HALF + m * 16;
                const float rs = rs8[ai][m];
                f32x4 a0 = acc[ai][0][m][0] * rs, a1 = acc[ai][0][m][1] * rs, b0 = acc[ai][1][m][0] * rs, b1 = acc[ai][1][m][1] * rs;
                if (u.pn >= 4) {
                    if (u.pn >= 10) {
                        PG8_GAS unsigned char* o8 = (PG8_GAS unsigned char*)OM + (size_t)row * 512 + (u.pn - 10) * 256 + wc * 32 + 8 * fq;
                        *(PG8_GAS u32x2*)(o8) = pack8_fp8(a0, a1); *(PG8_GAS u32x2*)(o8 + 128) = pack8_fp8(b0, b1);
                    } else {
                        gbf16* base = (u.pn < 8 ? QKM + (size_t)row * 1024 + (u.pn - 4) * 256 : VM + (size_t)row * 512 + (u.pn - 8) * 256) + wc * 32 + 8 * fq;
                        *(gu32x4*)(base) = pack8(a0, a1); *(gu32x4*)(base + 128) = pack8(b0, b1);
                    }
                } else {
                    const int slot = u.pn * 4 + wc;
                    if (slot < 9) {
                        float ss = (a0[0] * a0[0] + a0[1] * a0[1]) + (a0[2] * a0[2] + a0[3] * a0[3]) + (a1[0] * a1[0] + a1[1] * a1[1]) + (a1[2] * a1[2] + a1[3] * a1[3])
                                 + (b0[0] * b0[0] + b0[1] * b0[1]) + (b0[2] * b0[2] + b0[3] * b0[3]) + (b1[0] * b1[0] + b1[1] * b1[1]) + (b1[2] * b1[2] + b1[3] * b1[3]);
                        ss += shx(ss, 16, fr | (fq << 4)); ss += shx(ss, 32, fr | (fq << 4));
                        const float r2 = rsqrtf(ss * (1.0f / 64.0f) + EPS);
                        cgf32* gn = (slot < 8 ? qn : kn) + 8 * fq;
                        a0 = a0 * r2 * *(cgf32x4*)(gn); a1 = a1 * r2 * *(cgf32x4*)(gn + 4);
                        b0 = b0 * r2 * *(cgf32x4*)(gn + 32); b1 = b1 * r2 * *(cgf32x4*)(gn + 36);
                    }
                    if (slot < 14) {
                        cgf32* c = cs + (size_t)(row & (S - 1)) * 64 + 8 * fq;
                        const f32x4 c0 = *(cgf32x4*)(c), c1 = *(cgf32x4*)(c + 4), s0 = *(cgf32x4*)(c + 32), s1 = *(cgf32x4*)(c + 36);
                        const f32x4 o10 = a0 * c0 - b0 * s0, o11 = a1 * c1 - b1 * s1, o20 = b0 * c0 + a0 * s0, o21 = b1 * c1 + a1 * s1;
                        if (slot == 8) {
                            PG8_GAS unsigned char* d8 = (PG8_GAS unsigned char*)KV + (size_t)row * 128 + 8 * fq;
                            *(PG8_GAS u32x2*)(d8) = pack8_fp8(o10, o11); *(PG8_GAS u32x2*)(d8 + 32) = pack8_fp8(o20, o21);
                        } else if (slot < 8) {
                            PG8_GAS unsigned char* q8 = (PG8_GAS unsigned char*)Q + (size_t)row * 512 + slot * 64 + 8 * fq;
                            *(PG8_GAS u32x2*)(q8) = pack8_fp8(o10, o11); *(PG8_GAS u32x2*)(q8 + 32) = pack8_fp8(o20, o21);
                        } else {
                            gbf16* dst;
                            if (slot == 9) dst = KI + (size_t)row * 64;
                            else dst = QI + (size_t)row * 256 + (slot - 10) * 64;
                            dst += 8 * fq;
                            *(gu32x4*)(dst) = pack8(o10, o11); *(gu32x4*)(dst + 32) = pack8(o20, o21);
                        }
                    } else if (slot == 14) {
                        PG8_GAS unsigned char* d8 = (PG8_GAS unsigned char*)KV + (size_t)row * 128 + 64 + 8 * fq;
                        *(PG8_GAS u32x2*)(d8) = pack8_fp8(a0, a1); *(PG8_GAS u32x2*)(d8 + 32) = pack8_fp8(b0, b1);
                    } else {
                        gf32* g = GT + (size_t)row * 16;
                        if (fq == 0) { *(gf32x4*)(g) = a0 * (1.0f / 16.0f); *(gf32x4*)(g + 4) = a1 + *(cgf32x4*)(gate_b); }
                        else if (fq == 1) { *(gf32x4*)(g + 8) = a0 + *(cgf32x4*)(gate_b + 4); }
                    }
                }
            }
    }
};

template <class Epi, class Sched, bool ALIGN_EPI = false, bool SP2 = false, bool FP8 = false>
__device__ __forceinline__ void gemm_phase(PG8_LAS unsigned char* lds, const Gemm g, const Sched& S, const Epi& E, int tid_in) {
    int tid_raw = tid_in; asm volatile("" : "+v"(tid_raw));
    const int tid = tid_raw, wid = __builtin_amdgcn_readfirstlane(tid >> 6), lane = tid & 63, wr = wid >> 2, wc = wid & 3, fr = lane & 15, fq = lane >> 4;
    const int K = g.K, nt = K / BK;
    unsigned voffA[2], voffB[2];
#pragma unroll
    for (int i = 0; i < 2; ++i) { int R, C; stage_rc(tid * 16 + i * 8192, R, C); const int Rb = Epi::PERM ? ((R & ~31) + perm32(R & 31)) : R;
        voffA[i] = (unsigned)(R * K + C) * 2u; voffB[i] = (unsigned)(Rb * K + C) * 2u; }
    const size_t kstep = (size_t)(BK * 2);
    const size_t hstep = (size_t)HALF * K * 2;
    const size_t tstep = 2 * hstep;
    const unsigned ldsw = (unsigned)wid * 1024u;
    const int aoff = lds_byte(wr * 64 + fr, fq * 8), boff = lds_byte(wc * 32 + fr, fq * 8);
#define PG8_SA(b, h) (((b) * 2 + (h)) * HTB)
#define PG8_SB(b, h) ((4 + (b) * 2 + (h)) * HTB)
#define PG8_STAGE(bufoff, gbase, voff) do { _Pragma("unroll") for (int _i = 0; _i < 2; ++_i) \
        __builtin_amdgcn_global_load_lds((const unsigned*)((const char*)(gbase) + (voff)[_i]), (PG8_LAS unsigned*)(lds + (bufoff) + ldsw + _i * 8192), 16, 0, 0); } while (0)
#define PG8_LDA(dst, b, h) do { _Pragma("unroll") for (int m = 0; m < 4; ++m) _Pragma("unroll") for (int k = 0; k < 2; ++k) dst[m][k] = *(const PG8_LAS bf16x8*)(lds + PG8_SA(b, h) + aoff + m * 2048 + k * 1024); } while (0)
#define PG8_LDB(dst, b, h) do { _Pragma("unroll") for (int n = 0; n < 2; ++n) _Pragma("unroll") for (int k = 0; k < 2; ++k) dst[n][k] = *(const PG8_LAS bf16x8*)(lds + PG8_SB(b, h) + boff + n * 2048 + k * 1024); } while (0)
#define PG8_CAT(x0, x1) __builtin_shufflevector(__builtin_bit_cast(i32x4, x0), __builtin_bit_cast(i32x4, x1), 0, 1, 2, 3, 4, 5, 6, 7)
#define PG8_MMA(ai, bj, At, Bt) do { __builtin_amdgcn_s_setprio(1); \
        if constexpr (FP8) { _Pragma("unroll") for (int m = 0; m < 4; ++m) _Pragma("unroll") for (int n = 0; n < 2; ++n) \
            asm volatile("v_mfma_f32_16x16x128_f8f6f4 %0, %1, %2, %0" : "+v"(acc[ai][bj][m][n]) : "v"(PG8_CAT(Bt[n][0], Bt[n][1])), "v"(PG8_CAT(At[m][0], At[m][1]))); } \
        else { _Pragma("unroll") for (int m = 0; m < 4; ++m) _Pragma("unroll") for (int n = 0; n < 2; ++n) _Pragma("unroll") for (int k = 0; k < 2; ++k) \
            acc[ai][bj][m][n] = __builtin_amdgcn_mfma_f32_16x16x32_bf16(Bt[n][k], At[m][k], acc[ai][bj][m][n], 0, 0, 0); } \
        __builtin_amdgcn_s_setprio(0); } while (0)
#define PG8_GUARD do { if constexpr (FP8) asm volatile("s_nop 15\n\ts_nop 15" ::: "memory"); } while (0)
#define PG8_WAIT_V(n) asm volatile("s_waitcnt vmcnt(" #n ")" ::: "memory")
#define PG8_WAIT_L(n) asm volatile("s_waitcnt lgkmcnt(" #n ")" ::: "memory")
#define PG8_BAR __builtin_amdgcn_s_barrier()
#define PG8_SCHED __builtin_amdgcn_sched_barrier(0)
    Unit cur, nxt; int ui = 0;
    if (!S.next(0, cur)) return;
    f32x4 acc[2][2][4][2];
#pragma unroll
    for (int a = 0; a < 2; ++a)
#pragma unroll
        for (int b = 0; b < 2; ++b)
#pragma unroll
            for (int m = 0; m < 4; ++m)
#pragma unroll
                for (int n = 0; n < 2; ++n) acc[a][b][m][n] = (f32x4){0.f, 0.f, 0.f, 0.f};
    bf16x8 At[4][2], B0[2][2], B1[2][2];
    const char* cA = (const char*)g.A + (size_t)cur.pm * tstep; const char* cB = (const char*)g.Bt + (size_t)cur.pn * tstep;
    S.a_ready(cur);
    if constexpr (SP2) {
        PG8_STAGE(PG8_SB(0, 0), cB, voffB); PG8_STAGE(PG8_SB(0, 1), cB + hstep, voffB); PG8_STAGE(PG8_SA(0, 0), cA, voffA); PG8_STAGE(PG8_SA(0, 1), cA + hstep, voffA);
        if (wr == 1) PG8_BAR;
        PG8_WAIT_V(2); PG8_BAR;
        PG8_STAGE(PG8_SB(1, 0), cB + kstep, voffB); PG8_STAGE(PG8_SA(1, 0), cA + kstep, voffA); PG8_STAGE(PG8_SB(1, 1), cB + hstep + kstep, voffB);
        PG8_WAIT_V(6); PG8_BAR;
    } else {
        PG8_STAGE(PG8_SB(0, 0), cB, voffB); PG8_STAGE(PG8_SA(0, 0), cA, voffA); PG8_STAGE(PG8_SB(0, 1), cB + hstep, voffB); PG8_STAGE(PG8_SA(0, 1), cA + hstep, voffA);
        if (wr == 1) PG8_BAR;
        PG8_WAIT_V(4); PG8_BAR;
        PG8_STAGE(PG8_SB(1, 0), cB + kstep, voffB); PG8_STAGE(PG8_SA(1, 0), cA + kstep, voffA); PG8_STAGE(PG8_SB(1, 1), cB + hstep + kstep, voffB);
        PG8_WAIT_V(6); PG8_BAR;
    }
    for (;;) {
        const bool has_next = S.next(ui + 1, nxt);
        const char* nA = has_next ? (const char*)g.A + (size_t)nxt.pm * tstep : cA; const char* nB = has_next ? (const char*)g.Bt + (size_t)nxt.pn * tstep : cB;
        for (int t = 0; t < nt; t += 2) {
            const bool last = (t == nt - 2);
            const char* a1 = cA + (size_t)(t + 1) * kstep;
            const char* a2 = last ? nA : cA + (size_t)(t + 2) * kstep; const char* b2 = last ? nB : cB + (size_t)(t + 2) * kstep;
            const char* a3 = a2 + kstep; const char* b3 = b2 + kstep;
            if (last && has_next) S.a_ready(nxt);
            if constexpr (SP2) {
            PG8_LDB(B0, 0, 0); PG8_LDB(B1, 0, 1); PG8_SCHED; PG8_LDA(At, 0, 0); PG8_STAGE(PG8_SA(1, 1), a1 + hstep, voffA);
            PG8_WAIT_V(8); PG8_WAIT_L(0); PG8_BAR; PG8_MMA(0, 0, At, B0); PG8_MMA(0, 1, At, B1); PG8_BAR; PG8_GUARD; PG8_SCHED;
            PG8_LDA(At, 0, 1); PG8_STAGE(PG8_SB(0, 0), b2, voffB); PG8_STAGE(PG8_SB(0, 1), b2 + hstep, voffB); PG8_STAGE(PG8_SA(0, 0), a2, voffA);
            PG8_WAIT_V(8); PG8_WAIT_L(0); PG8_BAR; PG8_MMA(1, 0, At, B0); PG8_MMA(1, 1, At, B1); PG8_BAR; PG8_GUARD; PG8_SCHED;
            PG8_LDB(B0, 1, 0); PG8_LDB(B1, 1, 1); PG8_SCHED; PG8_LDA(At, 1, 0); PG8_STAGE(PG8_SA(0, 1), a2 + hstep, voffA);
            PG8_WAIT_V(8); PG8_WAIT_L(0); PG8_BAR; PG8_MMA(0, 0, At, B0); PG8_MMA(0, 1, At, B1); PG8_BAR; PG8_GUARD; PG8_SCHED;
            PG8_LDA(At, 1, 1); PG8_STAGE(PG8_SB(1, 0), b3, voffB); PG8_STAGE(PG8_SB(1, 1), b3 + hstep, voffB); PG8_STAGE(PG8_SA(1, 0), a3, voffA);
            PG8_WAIT_V(8); PG8_WAIT_L(0); PG8_BAR; PG8_MMA(1, 0, At, B0); PG8_MMA(1, 1, At, B1); PG8_BAR; PG8_GUARD; PG8_SCHED;
            } else {
            PG8_LDB(B0, 0, 0); PG8_SCHED; PG8_LDA(At, 0, 0); PG8_STAGE(PG8_SA(1, 1), a1 + hstep, voffA);
            PG8_WAIT_L(8); PG8_BAR; PG8_WAIT_L(0); PG8_MMA(0, 0, At, B0); PG8_BAR; PG8_SCHED;
            PG8_LDB(B1, 0, 1); PG8_STAGE(PG8_SB(0, 0), b2, voffB);
            PG8_BAR; PG8_WAIT_L(0); PG8_MMA(0, 1, At, B1); PG8_BAR;
            PG8_LDA(At, 0, 1); PG8_STAGE(PG8_SA(0, 0), a2, voffA);
            PG8_BAR; PG8_WAIT_L(0); PG8_MMA(1, 0, At, B0); PG8_BAR; PG8_SCHED;
            PG8_STAGE(PG8_SB(0, 1), b2 + hstep, voffB);
            PG8_WAIT_V(6); PG8_BAR; PG8_MMA(1, 1, At, B1); PG8_BAR;
            PG8_LDB(B0, 1, 0); PG8_SCHED; PG8_LDA(At, 1, 0); PG8_STAGE(PG8_SA(0, 1), a2 + hstep, voffA);
            PG8_WAIT_L(8); PG8_BAR; PG8_WAIT_L(0); PG8_MMA(0, 0, At, B0); PG8_BAR; PG8_SCHED;
            PG8_LDB(B1, 1, 1); PG8_STAGE(PG8_SB(1, 0), b3, voffB);
            PG8_BAR; PG8_WAIT_L(0); PG8_MMA(0, 1, At, B1); PG8_BAR;
            PG8_LDA(At, 1, 1); PG8_STAGE(PG8_SA(1, 0), a3, voffA);
            PG8_BAR; PG8_WAIT_L(0); PG8_MMA(1, 0, At, B0); PG8_BAR; PG8_SCHED;
            PG8_STAGE(PG8_SB(1, 1), b3 + hstep, voffB);
            PG8_WAIT_V(6); PG8_BAR; PG8_MMA(1, 1, At, B1); PG8_BAR;
            }
        }
        if constexpr (FP8) { asm volatile("s_nop 15\n\ts_nop 15\n\ts_nop 15" ::: "memory"); }
        if constexpr (ALIGN_EPI) { if (wr == 0) PG8_BAR; }
        if constexpr (!Epi::AFTER_DRAIN) { E(acc, cur, wr, wc, fr, fq); S.done(cur); }
        if (!has_next) break;
#pragma unroll
        for (int a = 0; a < 2; ++a)
#pragma unroll
            for (int b = 0; b < 2; ++b)
#pragma unroll
                for (int m = 0; m < 4; ++m)
#pragma unroll
                    for (int n = 0; n < 2; ++n) acc[a][b][m][n] = (f32x4){0.f, 0.f, 0.f, 0.f};
        cur = nxt; cA = nA; cB = nB; ++ui;
        if constexpr (ALIGN_EPI) { if (wr == 1) PG8_BAR; }
    }
    PG8_WAIT_V(0);
    if constexpr (!ALIGN_EPI) { if (wr == 0) PG8_BAR; }
    PG8_BAR;
    if constexpr (Epi::AFTER_DRAIN) { E.fused(acc, cur, wr, wc, fr, fq, lds, wid, lane); S.done(cur); }
#undef PG8_SA
#undef PG8_SB
#undef PG8_STAGE
#undef PG8_LDA
#undef PG8_LDB
#undef PG8_MMA
#undef PG8_CAT
#undef PG8_WAIT_V
#undef PG8_GUARD
#undef PG8_WAIT_L
#undef PG8_BAR
#undef PG8_SCHED
}
}
#define GAS __attribute__((address_space(1)))
#define LAS __attribute__((address_space(3)))
typedef unsigned v4u __attribute__((ext_vector_type(4)));
typedef float f32x4 __attribute__((ext_vector_type(4)));
typedef short bf16x8 __attribute__((ext_vector_type(8)));
typedef GAS unsigned gu32;
#define RLX_AGENT __ATOMIC_RELAXED, __HIP_MEMORY_SCOPE_AGENT
#define LDS_WAIT() asm volatile("s_waitcnt lgkmcnt(0)" ::: "memory")
#define VM_WAIT() asm volatile("s_waitcnt vmcnt(0)" ::: "memory")
__device__ __forceinline__ unsigned f2bf(float f) { unsigned u = __builtin_bit_cast(unsigned, f); return (u + 0x7fffu + ((u >> 16) & 1u)) >> 16; }
__device__ __forceinline__ unsigned pk2(float lo, float hi) { unsigned r; asm("v_cvt_pk_bf16_f32 %0, %1, %2" : "=v"(r) : "v"(lo), "v"(hi)); return r; }
__device__ __forceinline__ float bf2f(unsigned short b) { return __builtin_bit_cast(float, (unsigned)b << 16); }

constexpr size_t MiB = 1u << 20;
constexpr size_t WS_CTL = 0, CTL_ZERO_BYTES = 1 * MiB;
constexpr size_t WS_CS = 1 * MiB;
constexpr size_t WS_SS = 3 * MiB;
constexpr size_t WS_W = 5 * MiB;
constexpr size_t W_UP = (size_t)2 * DFF * D * 2, W_DN = (size_t)D * DFF * 2, W_IN = (size_t)INP * D * 2, W_OUT = (size_t)D * D * 2;
constexpr size_t WO_U1 = 0, WO_D1 = WO_U1 + W_UP, WO_IN = WO_D1 + W_DN, WO_OUT = WO_IN + W_IN, WO_U2 = WO_OUT + W_OUT, WO_D2 = WO_U2 + W_UP, W_LAYER = WO_D2 + W_DN;
static_assert(W_LAYER == 41 * MiB, "weights per layer");
constexpr size_t WS_XB = 87 * MiB;
constexpr size_t WS_BIG = 151 * MiB;
constexpr size_t WS_XB8 = WS_BIG + 96 * MiB;
constexpr size_t WS_ACT = WS_BIG;
constexpr size_t WS_Q = WS_BIG, WS_KV = WS_Q + 32 * MiB, WS_QI = WS_KV + 8 * MiB, WS_KI = WS_QI + 16 * MiB, WS_GT = WS_KI + 4 * MiB, WS_QKM = WS_GT + 2 * MiB,
                 WS_VM = WS_QKM + 64 * MiB, WS_OM = WS_VM + 32 * MiB, WS_MIX = WS_OM + 32 * MiB, WS_CC = WS_MIX + 64 * MiB, WS_CP = WS_CC + 64 * MiB,
                 WS_NC = WS_CP + 32 * MiB, WS_NP = WS_NC + MiB / 2, WS_SC = WS_NP + MiB / 2, WS_END = WS_SC + MiB;
static_assert(WS_MIX >= WS_ACT + (size_t)T * DFF * 2 || true, "");
static_assert(WS_END <= 512 * MiB, "workspace map");
constexpr int CW_BAR = 4096;
constexpr int RING_BYTES = 131072, LDSCTL_OFF = RING_BYTES, MISC_OFF = LDSCTL_OFF + 320, LDS_BYTES = 147456, LDS_TAB_OFF = LDSCTL_OFF + 2048;
constexpr int NWAVES = 8, NTHR = 512;

__device__ __forceinline__ int my_lane_volatile() { int x; asm volatile("v_mbcnt_lo_u32_b32 %0, -1, 0\n\tv_mbcnt_hi_u32_b32 %0, -1, %0" : "=v"(x)); return x; }
#define XB_TMO      128
#define XB_XCNT(j)  (256  + 64 * (j))
#define XB_XSUB(j)  (1280 + 64 * (j))
#define XB_XGEN(j)  (2304 + 64 * (j))
#define XB_TOP      3328
#define XB_TOPGEN   3392
#define XCD_BAR_WORDS 3456
#define XB_SPIN_CAP (1u << 18)

__device__ __forceinline__ unsigned xb_ld(unsigned* p)              { return __hip_atomic_load(p, __ATOMIC_RELAXED, __HIP_MEMORY_SCOPE_AGENT); }
__device__ __forceinline__ unsigned xb_add(unsigned* p, unsigned v) { return __hip_atomic_fetch_add(p, v, __ATOMIC_RELAXED, __HIP_MEMORY_SCOPE_AGENT); }
__device__ __forceinline__ unsigned xb_xcc_id() { return (unsigned)__builtin_amdgcn_s_getreg((3 << 11) | 20) & 0xFu; }
#define XB_SPIN(cond, bar) do { unsigned _sp = 0; while (cond) { __builtin_amdgcn_s_sleep(1); \
    if ((++_sp & 255u) == 0u) { if (xb_ld(&(bar)[XB_TMO])) break; if (_sp > XB_SPIN_CAP) { atomicAdd(&(bar)[XB_TMO], 1u); break; } } } } while (0)

struct XcdBarrier {
    unsigned* bar; unsigned x;
    volatile LAS unsigned* st; int wave;
};

__device__ __forceinline__ XcdBarrier xcd_barrier_post(unsigned* bar, volatile LAS unsigned* st, int wave) {
    XcdBarrier b; b.bar = bar; b.x = xb_xcc_id(); b.st = st; b.wave = wave;
    if (wave == 0 && my_lane_volatile() == 0) (void)xb_add(&bar[XB_XCNT(b.x)], 1u);
    return b;
}
__device__ __forceinline__ void xcd_barrier_complete(unsigned* bar, unsigned x, unsigned& nloc, unsigned& nx) {
    const unsigned G = gridDim.x * gridDim.y * gridDim.z;
    unsigned sum, cnt, mine, sp = 0u;
    for (;;) {
        sum = 0u; cnt = 0u; mine = 0u;
#pragma unroll
        for (unsigned j = 0; j < 16; ++j) { const unsigned c = xb_ld(&bar[XB_XCNT(j)]); sum += c; cnt += (c > 0u) ? 1u : 0u; mine = (j == x) ? c : mine; }
        if (sum == G) break;
        __builtin_amdgcn_s_sleep(1);
        if ((++sp & 255u) == 0u) { if (xb_ld(&bar[XB_TMO])) break; if (sp > XB_SPIN_CAP) { atomicAdd(&bar[XB_TMO], 1u); break; } }
    }
    nloc = mine > 0u ? mine : 1u; nx = cnt > 0u ? cnt : 1u;
}

__device__ __forceinline__ void xcd_barrier(const XcdBarrier& b) {
    asm volatile("s_waitcnt vmcnt(0)" ::: "memory");
    __syncthreads();
    if (b.wave == 0 && my_lane_volatile() == 0) {
        unsigned* bar = b.bar;
        __builtin_amdgcn_s_waitcnt(0);
        unsigned nloc = b.st[0], nx = b.st[1];
        if (nloc == 0u) { xcd_barrier_complete(bar, b.x, nloc, nx); b.st[0] = nloc; b.st[1] = nx; }
        const unsigned old = xb_add(&bar[XB_XSUB(b.x)], 1u);
        const unsigned gen = old / nloc;
        if (old + 1u == (gen + 1u) * nloc) {
            __builtin_amdgcn_fence(__ATOMIC_RELEASE, "agent");
            asm volatile("s_waitcnt vmcnt(0)" ::: "memory");
            const unsigned og = xb_add(&bar[XB_TOP], 1u);
            const unsigned tg = og / nx;
            if (og + 1u == (tg + 1u) * nx) xb_add(&bar[XB_TOPGEN], 1u);
            else XB_SPIN(xb_ld(&bar[XB_TOPGEN]) == tg, bar);
            __builtin_amdgcn_fence(__ATOMIC_ACQUIRE, "agent");
            xb_add(&bar[XB_XGEN(b.x)], 1u);
            asm volatile("s_waitcnt vmcnt(0)" ::: "memory");
        } else {
            XB_SPIN(xb_ld(&bar[XB_XGEN(b.x)]) == gen, bar);
            __builtin_amdgcn_fence(__ATOMIC_ACQUIRE, "agent");
            asm volatile("s_waitcnt vmcnt(0)" ::: "memory");
        }
    }
    __syncthreads();
}

struct Params {
    const float* in[18]; float* out; unsigned char* ws;
    int ph_lo, ph_hi, li, flags;
};
enum { I_X = 0, I_F1N = 1, I_F1G = 2, I_F1U = 3, I_F1D = 4, I_MN = 5, I_WIN = 6, I_CW = 7, I_CB = 8, I_GB = 9, I_QN = 10, I_KN = 11, I_MNORM = 12, I_WOUT = 13, I_F2N = 14, I_F2G = 15, I_F2U = 16, I_F2D = 17 };

__device__ __forceinline__ float wave_sum(float v, int lane) {
#pragma unroll
    for (int o = 1; o < 64; o <<= 1) v += shx(v, o, lane);
    return v;
}
__device__ __forceinline__ int win_src(int p) {
    if (p >= 1024) return p < 2048 ? C_QKM + (p - 1024) : (p < 2560 ? C_VM + (p - 2048) : C_OM + (p - 2560));
    const int pn = p >> 8, r = p & 255, bj = r >> 7, wc = (r >> 5) & 3, dd = r & 31, slot = pn * 4 + wc, d = 32 * bj + dd;
    if (slot < 8) return C_Q + slot * 64 + d;
    if (slot == 8) return C_K + d;
    if (slot == 9) return C_KI + d;
    if (slot < 14) return C_QI + (slot - 10) * 64 + d;
    if (slot == 14) return C_V + d;
    if (d < 4) return C_WI + d;
    if (d < 8) return C_IG + d - 4;
    if (d < 12) return C_FG + d - 8;
    return -1;
}
__device__ __forceinline__ void tr_item(const float* W, int ldw, int K, bf16_t* WT, int n0, int k0, int srccol, const float* gain, LAS float* scr, int lane, float f8scale) {
    float v[32];
#pragma unroll
    for (int i = 0; i < 32; ++i) { const int kk = 2 * i + (lane >> 5); v[i] = srccol >= 0 ? W[(size_t)(k0 + kk) * ldw + srccol] : 0.f; }
    if (gain) {
#pragma unroll
        for (int i = 0; i < 32; ++i) v[i] *= gain[k0 + 2 * i + (lane >> 5)];
    }
#pragma unroll
    for (int i = 0; i < 32; ++i) scr[(2 * i + (lane >> 5)) * 33 + (lane & 31)] = v[i];
    LDS_WAIT(); asm volatile("" ::: "memory");
    const int c = lane & 7;
    if (f8scale > 0.f) {
#pragma unroll
        for (int j = 0; j < 4; ++j) { const int n = (lane >> 3) + 8 * j; const LAS float* s = scr + (8 * c) * 33 + n;
            unsigned lo = 0u, hi = 0u;
            lo = __builtin_amdgcn_cvt_pk_fp8_f32(s[0 * 33] * f8scale, s[1 * 33] * f8scale, lo, false); lo = __builtin_amdgcn_cvt_pk_fp8_f32(s[2 * 33] * f8scale, s[3 * 33] * f8scale, lo, true);
            hi = __builtin_amdgcn_cvt_pk_fp8_f32(s[4 * 33] * f8scale, s[5 * 33] * f8scale, hi, false); hi = __builtin_amdgcn_cvt_pk_fp8_f32(s[6 * 33] * f8scale, s[7 * 33] * f8scale, hi, true);
            *(GAS unsigned long long*)((GAS unsigned char*)WT + (size_t)(n0 + n) * K + k0 + 8 * c) = (unsigned long long)lo | ((unsigned long long)hi << 32); }
    } else {
#pragma unroll
    for (int j = 0; j < 4; ++j) { const int n = (lane >> 3) + 8 * j; const LAS float* s = scr + (8 * c) * 33 + n;
        v4u o; o.x = pk2(s[0 * 33], s[1 * 33]); o.y = pk2(s[2 * 33], s[3 * 33]); o.z = pk2(s[4 * 33], s[5 * 33]); o.w = pk2(s[6 * 33], s[7 * 33]);
        *(GAS v4u*)(WT + (size_t)(n0 + n) * K + k0 + 8 * c) = o; }
    }
    LDS_WAIT(); asm volatile("" ::: "memory");
}
__device__ __forceinline__ void sincos_acc(float ang, float& c, float& s) {
    const double TWO_PI = 6.283185307179586476925286766559, INV_TWO_PI = 0.15915494309189533576888376337251;
    const double a = (double)ang, k = rint(a * INV_TWO_PI), r = a - k * TWO_PI, r2 = r * r;
    double sn = 0.0, cn = 0.0, ts = r, tc = 1.0;
#pragma unroll
    for (int i = 0; i < 15; ++i) { sn += ts; cn += tc; tc = -tc * r2 * (1.0 / (double)((2 * i + 1) * (2 * i + 2))); ts = -ts * r2 * (1.0 / (double)((2 * i + 2) * (2 * i + 3))); }
    c = (float)cn; s = (float)sn;
}
__device__ __forceinline__ void p0_prologue(const Params& P, LAS unsigned char* lds, int vcu, int G, int wave, int lane) {
    LAS float* scr = (LAS float*)(lds + wave * 16384);
    const int gw = vcu * NWAVES + wave, NGW = G * NWAVES;
    unsigned char* ws = P.ws;
    constexpr int I_UP = (D / 64) * (2 * DFF / 32), I_DN = (DFF / 64) * (D / 32), I_IN = (D / 64) * (INP / 32), I_OUT = (D / 64) * (D / 32);
    constexpr int I_LAYER = 2 * I_UP + 2 * I_DN + I_IN + I_OUT;
    for (int it = gw; it < DEPTH * I_LAYER; it += NGW) {
        const int l = it / I_LAYER; int r = it % I_LAYER;
        const float* W; const float* gain = nullptr; int ldw, K, nblk, src_mode; size_t wo; float f8 = 0.f;
        if (r < 2 * I_UP) { const int f = r / I_UP; r -= f * I_UP; ldw = DFF; K = D; nblk = 2 * DFF / 32; src_mode = f; wo = f ? WO_U2 : WO_U1; gain = P.in[f ? I_F2N : I_F1N] + l * D; W = nullptr;
                            if (FP8UPLAST && ((l == DEPTH - 1 && (f == 1 || FP8UPLAST >= 2)) || (FP8UPLAST >= 3 && l == DEPTH - 2 && f == 1))) f8 = pg8::WUP_SCALE; }
        else if (r < 2 * I_UP + 2 * I_DN) { r -= 2 * I_UP; const int f = r / I_DN; r -= f * I_DN; ldw = D; K = DFF; nblk = D / 32; src_mode = 2; wo = f ? WO_D2 : WO_D1; W = P.in[f ? I_F2D : I_F1D] + (size_t)l * DFF * D; f8 = FP8DOWN ? pg8::WDN_SCALE : 0.f; }
        else if (r < 2 * I_UP + 2 * I_DN + I_IN) { r -= 2 * I_UP + 2 * I_DN; ldw = INC; K = D; nblk = INP / 32; src_mode = 3; wo = WO_IN; gain = P.in[I_MN] + l * D; W = P.in[I_WIN] + (size_t)l * D * INC; }
        else { r -= 2 * I_UP + 2 * I_DN + I_IN; ldw = D; K = D; nblk = D / 32; src_mode = 2; wo = WO_OUT; W = P.in[I_WOUT] + (size_t)l * D * D; }
        const int kb = r / nblk, nb = r % nblk, n0 = 32 * nb, k0 = 64 * kb;
        int src = n0 + (lane & 31);
        if (src_mode < 2) {
            const int pn = n0 >> 8, rr = n0 & 255;
            W = (rr < 128 ? P.in[src_mode ? I_F2G : I_F1G] : P.in[src_mode ? I_F2U : I_F1U]) + (size_t)l * D * DFF;
            src = 128 * pn + (rr & 127) + (lane & 31);
        } else if (src_mode == 3) src = win_src(src);
        tr_item(W, ldw, K, (bf16_t*)(ws + WS_W + (size_t)l * W_LAYER + wo), n0, k0, src, gain, scr, lane, f8);
    }
    {
        const float* x = P.in[I_X]; bf16_t* XB = (bf16_t*)(ws + WS_XB); float* SS = (float*)(ws + WS_SS);
        for (int m0 = gw * 4; m0 < T; m0 += NGW * 4) {
            f32x4 v[4][4];
#pragma unroll
            for (int r = 0; r < 4; ++r) { const GAS f32x4* xr = (const GAS f32x4*)(x + (size_t)(m0 + r) * D) + lane;
#pragma unroll
                for (int j = 0; j < 4; ++j) v[r][j] = xr[64 * j]; }
#pragma unroll
            for (int r = 0; r < 4; ++r) { float s = 0.f;
#pragma unroll
                for (int j = 0; j < 4; ++j) s += (v[r][j][0] * v[r][j][0] + v[r][j][1] * v[r][j][1]) + (v[r][j][2] * v[r][j][2] + v[r][j][3] * v[r][j][3]);
                s = wave_sum(s, lane);
                GAS unsigned long long* o8 = (GAS unsigned long long*)(XB + (size_t)(m0 + r) * D) + lane;
#pragma unroll
                for (int j = 0; j < 4; ++j) o8[64 * j] = (unsigned long long)pk2(v[r][j][0], v[r][j][1]) | ((unsigned long long)pk2(v[r][j][2], v[r][j][3]) << 32);
                if (lane < 16) SS[(size_t)(m0 + r) * 16 + lane] = lane == 0 ? s : 0.f; }
        }
    }
    {
        float* cs = (float*)(ws + WS_CS);
        for (int i = gw * 64 + lane; i < S * 32; i += NGW * 64) {
            const int pos = i >> 5, j = i & 31; float c, s;
            double fr = 1.0; for (int q = 0; q < j; ++q) fr *= 0.74989420933245582730;
            sincos_acc((float)pos * (float)fr, c, s);
            cs[pos * 64 + j] = c; cs[pos * 64 + 32 + j] = s;
        }
    }
}
typedef short v4i16_t __attribute__((ext_vector_type(4)));
typedef float f32x2_t __attribute__((ext_vector_type(2)));
typedef GAS float gf32; typedef const GAS float cgf32; typedef GAS bf16_t gbf; typedef const GAS bf16_t cgbf;
typedef const GAS v4u cgv4u; typedef GAS v4u gv4u; typedef const GAS f32x4 cgf32x4;
__device__ __forceinline__ v4i16_t tr16(LAS const unsigned char* p) { return __builtin_amdgcn_ds_read_tr16_b64_v4i16((LAS v4i16_t*)p); }
__device__ __forceinline__ bf16x8 cat8(v4i16_t lo, v4i16_t hi) { bf16x8 r; r[0] = lo[0]; r[1] = lo[1]; r[2] = lo[2]; r[3] = lo[3]; r[4] = hi[0]; r[5] = hi[1]; r[6] = hi[2]; r[7] = hi[3]; return r; }
__device__ __forceinline__ pg8::f32x4 mfma16(bf16x8 a, bf16x8 b, pg8::f32x4 c) {
    c = __builtin_amdgcn_mfma_f32_16x16x32_bf16(a, b, c, 0, 0, 0);
    asm volatile("s_nop 3" : "+v"(c) : "v"(a), "v"(b));
    return c;
}
__device__ __forceinline__ unsigned opaque0() { unsigned z; asm volatile("v_mov_b32 %0, 0" : "=v"(z)); return z; }
__device__ __forceinline__ float fast_sigmoid(float x) { return __builtin_amdgcn_rcpf(1.0f + __builtin_amdgcn_exp2f(-1.4426950408889634f * x)); }
__device__ __forceinline__ float fast_exp(float x) { return __builtin_amdgcn_exp2f(1.4426950408889634f * x); }
constexpr int ML_UNITS = NB * 4 * 64;
constexpr int ST_T = 288, ST_R = 272;
constexpr float KSCALE = 0.08838834764831845f;

__device__ __forceinline__ float lane63(float x) { return __builtin_bit_cast(float, __builtin_amdgcn_readlane(__builtin_bit_cast(int, x), 63)); }
__device__ __forceinline__ float scan_add(float x, int lane) {
#pragma unroll
    for (int d = 1; d < 64; d <<= 1) { const float y = shfrom(x, lane - d); x += (lane >= d) ? y : 0.f; }
    return x;
}
__device__ __forceinline__ float scan_max(float x, int lane) {
#pragma unroll
    for (int d = 1; d < 64; d <<= 1) { const float y = shfrom(x, lane - d); x = (lane >= d) ? fmaxf(x, y) : x; }
    return x;
}
__device__ __forceinline__ void ml_gates_reg(cgf32* GT, int tok0, int h, int wave, int lane, float& bt, float& ct, float& pm, float& bl, float& cmax) {
    const float f0 = GT[(size_t)(tok0 + lane) * 16 + 8 + h], i0 = GT[(size_t)(tok0 + lane) * 16 + 4 + h];
    const float f1 = GT[(size_t)(tok0 + 64 + lane) * 16 + 8 + h], i1 = GT[(size_t)(tok0 + 64 + lane) * 16 + 4 + h];
    const float l0 = fminf(f0, 0.f) - 0.6931471805599453f * __builtin_amdgcn_logf(1.0f + __builtin_amdgcn_exp2f(-1.4426950408889634f * fabsf(f0))), l1 = fminf(f1, 0.f) - 0.6931471805599453f * __builtin_amdgcn_logf(1.0f + __builtin_amdgcn_exp2f(-1.4426950408889634f * fabsf(f1)));
    const float b0 = scan_add(l0, lane), tot0 = lane63(b0), b1 = scan_add(l1, lane) + tot0;
    const float c0 = i0 - b0, c1 = i1 - b1;
    const float p0 = scan_max(c0, lane), m0 = lane63(p0), p1 = fmaxf(scan_max(c1, lane), m0);
    bl = lane63(b1); cmax = lane63(p1);
    bt = wave ? b1 : b0; ct = wave ? c1 : c0; pm = wave ? p1 : p0;
}
__device__ __forceinline__ void ml_conv_tile(cgbf* QKM, cgf32* cw, cgf32* cb, int tok0, int c, int col0, LAS unsigned char* img, int stride, float scl, const LAS float* rowscale, int tid, unsigned Z) {
    const int dg = tid & 15, r4 = tid >> 4, t0 = 4 * r4;
    v4u x[7];
#pragma unroll
    for (int j = 0; j < 7; ++j) { const int tt = t0 - 3 + j; const bool ok = (tt >= 0) || (c > 0);
        x[j] = *(cgv4u*)(QKM + (size_t)(tok0 + (ok ? tt : 0)) * 1024 + col0 + 8 * dg);
        if (!ok) x[j] = (v4u){Z, Z, Z, Z}; }
    float w[4][8], bb[8];
#pragma unroll
    for (int j = 0; j < 4; ++j) { const f32x4 a = *(cgf32x4*)(cw + j * 1024 + col0 + 8 * dg), b = *(cgf32x4*)(cw + j * 1024 + col0 + 8 * dg + 4);
#pragma unroll
        for (int e = 0; e < 4; ++e) { w[j][e] = a[e]; w[j][4 + e] = b[e]; } }
    { const f32x4 a = *(cgf32x4*)(cb + col0 + 8 * dg), b = *(cgf32x4*)(cb + col0 + 8 * dg + 4);
#pragma unroll
      for (int e = 0; e < 4; ++e) { bb[e] = a[e]; bb[4 + e] = b[e]; } }
#pragma unroll
    for (int r = 0; r < 4; ++r) {
        float y[8];
#pragma unroll
        for (int e = 0; e < 8; ++e) y[e] = bb[e];
#pragma unroll
        for (int j = 0; j < 4; ++j)
#pragma unroll
            for (int e = 0; e < 4; ++e) { y[2 * e] += w[j][2 * e] * __builtin_bit_cast(float, x[r + j][e] << 16); y[2 * e + 1] += w[j][2 * e + 1] * __builtin_bit_cast(float, x[r + j][e] & 0xffff0000u); }
        const float sc = rowscale ? scl * rowscale[t0 + r] : scl;
#pragma unroll
        for (int e = 0; e < 8; ++e) y[e] = y[e] * fast_sigmoid(y[e]) * sc;
        v4u o; o.x = pk2(y[0], y[1]); o.y = pk2(y[2], y[3]); o.z = pk2(y[4], y[5]); o.w = pk2(y[6], y[7]);
        *(LAS v4u*)(img + (t0 + r) * stride + 16 * dg) = o;
    }
}
__device__ __forceinline__ void ml_v_tile(cgbf* VM, int tok0, int h, LAS unsigned char* img, int tid, unsigned Z) {
    const int dg = tid & 15, tr = tid >> 4;
#pragma unroll
    for (int i = 0; i < 4; ++i) { const int t = tr + 32 * i;
        *(LAS v4u*)(img + t * ST_T + 16 * dg) = *(cgv4u*)(VM + (size_t)(tok0 + t) * 512 + h * 128 + 8 * dg); }
    if (tid < 128) { *(LAS v4u*)(img + tid * ST_T + 256) = (v4u){Z | 0x3F80u, Z, Z, Z}; *(LAS v4u*)(img + tid * ST_T + 272) = (v4u){Z, Z, Z, Z}; }
}

__device__ __forceinline__ void ml_phase1(unsigned char* ws, cgf32* cw, cgf32* cb, LAS unsigned char* lds, int G, int bx, int tid_in, int wave, int lane_in) {
    int tid = tid_in, lane = lane_in;
    LAS unsigned char* KIMG = lds; LAS unsigned char* VIMG = lds + 128 * ST_T;
    LAS float* lf = (LAS float*)(lds + 2 * 128 * ST_T); LAS float* ig = lf + 128; LAS float* bc = ig + 128; LAS float* wa = bc + 128;
    cgf32* GT = (cgf32*)(ws + WS_GT); cgbf* QKM = (cgbf*)(ws + WS_QKM); cgbf* VM = (cgbf*)(ws + WS_VM);
    gf32* CC = (gf32*)(ws + WS_CC); gf32* NC = (gf32*)(ws + WS_NC); gf32* SCL = (gf32*)(ws + WS_SC);
    for (int unit = bx; unit < ML_UNITS; unit += G) {
        lane = my_lane_volatile(); tid = (wave << 6) | lane;
        const int g = lane >> 4, q = (lane >> 2) & 3, p = lane & 3;
        const unsigned Z = opaque0();
        const int c = unit & 63, h = (unit >> 6) & 3, b = unit >> 8, tok0 = b * S + c * 128;
        if (tid < 128) {
            float bt, ct, pm, bl, cmax; ml_gates_reg(GT, tok0, h, wave, lane, bt, ct, pm, bl, cmax);
            const float am = bl + cmax;
            wa[tid] = __expf(bl + ct - am);
            if (tid == 0) { SCL[unit * 4 + 0] = bl; SCL[unit * 4 + 1] = am; }
        }
        __syncthreads();
        ml_conv_tile(QKM, cw, cb, tok0, c, 512 + h * 128, KIMG, ST_T, __builtin_bit_cast(float, Z | 0x3db504f3u)  , wa, tid, Z);
        ml_v_tile(VM, tok0, h, VIMG, tid, Z);
        __syncthreads();
        bf16x8 af[4];
#pragma unroll
        for (int ks = 0; ks < 4; ++ks) { const LAS unsigned char* a = KIMG + (32 * ks + 8 * g + q) * ST_T + 32 * wave + 8 * p; af[ks] = cat8(tr16(a), tr16(a + 4 * ST_T)); }
        bf16x8 ones;
#pragma unroll
        for (int e = 0; e < 8; ++e) ones[e] = (short)0x3F80;
        pg8::f32x4 accn = {0.f, 0.f, 0.f, 0.f};
#pragma unroll
        for (int ks = 0; ks < 4; ++ks) accn = mfma16(af[ks], ones, accn);
        gf32* ccu = CC + (size_t)unit * 16384 + (size_t)(16 * wave + 4 * g) * 128 + (lane & 15);
#pragma unroll
        for (int nt = 0; nt < 8; ++nt) {
            pg8::f32x4 acc = {0.f, 0.f, 0.f, 0.f};
#pragma unroll
            for (int ks = 0; ks < 4; ++ks) { const LAS unsigned char* a = VIMG + (32 * ks + 8 * g + q) * ST_T + 32 * nt + 8 * p; const bf16x8 bfr = cat8(tr16(a), tr16(a + 4 * ST_T));
                acc = mfma16(af[ks], bfr, acc); }
#pragma unroll
            for (int r = 0; r < 4; ++r) ccu[r * 128 + 16 * nt] = acc[r];
        }
        if ((lane & 15) == 0) {
#pragma unroll
            for (int r = 0; r < 4; ++r) NC[unit * 128 + 16 * wave + 4 * g + r] = accn[r];
        }
        __syncthreads();
    }
}
__device__ __forceinline__ void ml_phase2(unsigned char* ws, int G, int bx, int tid) {
    cgf32* CC = (cgf32*)(ws + WS_CC); cgf32* NC = (cgf32*)(ws + WS_NC); gf32* SCL = (gf32*)(ws + WS_SC);
    GAS unsigned* CP = (GAS unsigned*)(ws + WS_CP); gf32* NP = (gf32*)(ws + WS_NP);
    const int gt = bx * NTHR + tid, GT_ = G * NTHR;
    for (int idx = gt; idx < 16 * 8192; idx += GT_) {
        const int pr = idx >> 13, e2 = idx & 8191;
        float m = 0.f, c0 = 0.f, c1 = 0.f;
        for (int cg = 0; cg < 64; cg += 16) {
            float bl[16], am[16]; f32x2_t cc[16];
#pragma unroll
            for (int k = 0; k < 16; ++k) { const int unit = pr * 64 + cg + k; bl[k] = SCL[unit * 4 + 0]; am[k] = SCL[unit * 4 + 1]; cc[k] = *(const GAS f32x2_t*)(CC + (size_t)unit * 16384 + 2 * e2); }
            asm volatile("" ::: "memory");
#pragma unroll
            for (int k = 0; k < 16; ++k) { const int unit = pr * 64 + cg + k;
                CP[(size_t)unit * 8192 + e2] = pk2(c0, c1);
                if (e2 == 0) SCL[unit * 4 + 2] = m;
                const float mn = fmaxf(bl[k] + m, am[k]), so = __expf(bl[k] + m - mn), sn = __expf(am[k] - mn);
                c0 = so * c0 + sn * cc[k].x; c1 = so * c1 + sn * cc[k].y; m = mn; }
            asm volatile("" ::: "memory");
        }
    }
    for (int idx = gt; idx < 16 * 128; idx += GT_) {
        const int pr = idx >> 7, d = idx & 127;
        float m = 0.f, n = 0.f;
        for (int cg = 0; cg < 64; cg += 16) {
            float bl[16], am[16], nc[16];
#pragma unroll
            for (int k = 0; k < 16; ++k) { const int unit = pr * 64 + cg + k; bl[k] = SCL[unit * 4 + 0]; am[k] = SCL[unit * 4 + 1]; nc[k] = NC[unit * 128 + d]; }
            asm volatile("" ::: "memory");
#pragma unroll
            for (int k = 0; k < 16; ++k) { const int unit = pr * 64 + cg + k;
                NP[unit * 128 + d] = n;
                const float mn = fmaxf(bl[k] + m, am[k]), so = __expf(bl[k] + m - mn), sn = __expf(am[k] - mn);
                n = so * n + sn * nc[k]; m = mn; }
            asm volatile("" ::: "memory");
        }
    }
}
__device__ __forceinline__ void ml_phase3(unsigned char* ws, cgf32* cw, cgf32* cb, cgf32* mnorm, LAS unsigned char* lds, int G, int bx, int tid_in, int wave, int lane_in) {
    int tid = tid_in, lane = lane_in;
    LAS unsigned char* QIMG = lds; LAS unsigned char* KIMG = lds + 128 * ST_R; LAS unsigned char* VIMG = lds + 2 * 128 * ST_R; LAS unsigned char* CIMG = lds;
    LAS float* lf = (LAS float*)(lds + 2 * 128 * ST_R + 128 * ST_T); LAS float* ig = lf + 128; LAS float* bc = ig + 128;
    LAS float* rowt = bc + 128; LAS float* colt = rowt + 128; LAS float* wint = colt + 128; LAS float* flo = wint + 128;
    cgf32* GT = (cgf32*)(ws + WS_GT); cgbf* QKM = (cgbf*)(ws + WS_QKM); cgbf* VM = (cgbf*)(ws + WS_VM); cgbf* OM = (cgbf*)(ws + WS_OM);
    cgf32* SCL = (cgf32*)(ws + WS_SC); cgf32* NP = (cgf32*)(ws + WS_NP); cgbf* CP = (cgbf*)(ws + WS_CP); gbf* MIX = (gbf*)(ws + WS_MIX);
    for (int unit = bx; unit < ML_UNITS; unit += G) {
        lane = my_lane_volatile(); tid = (wave << 6) | lane;
        const int g = lane >> 4, q = (lane >> 2) & 3, p = lane & 3, l15 = lane & 15;
        const unsigned Z = opaque0();
        const int c = unit & 63, h = (unit >> 6) & 3, b = unit >> 8, tok0 = b * S + c * 128;
        v4u cpr[4];
#pragma unroll
        for (int i = 0; i < 4; ++i) cpr[i] = *(cgv4u*)(CP + (size_t)unit * 16384 + (size_t)(tid + 512 * i) * 8);
        if (tid < 128) {
            float bt, ct, pm, bl, cmax; ml_gates_reg(GT, tok0, h, wave, lane, bt, ct, pm, bl, cmax);
            const float mp = SCL[unit * 4 + 2], gt = bt + mp, mt = fmaxf(gt, bt + pm);
            rowt[tid] = bt - mt; colt[tid] = ct; wint[tid] = __expf(gt - mt); flo[tid] = __expf(-mt);
        }
        ml_conv_tile(QKM, cw, cb, tok0, c, h * 128, QIMG, ST_R, 1.0f, nullptr, tid, Z);
        ml_conv_tile(QKM, cw, cb, tok0, c, 512 + h * 128, KIMG, ST_R, __builtin_bit_cast(float, Z | 0x3db504f3u), nullptr, tid, Z);
        ml_v_tile(VM, tok0, h, VIMG, tid, Z);
        __syncthreads();
        bf16x8 qf[4];
#pragma unroll
        for (int ks = 0; ks < 4; ++ks) qf[ks] = *(const LAS bf16x8*)(QIMG + (16 * wave + l15) * ST_R + 64 * ks + 16 * g);
        const int tq = 16 * wave + l15; const float rt = rowt[tq], wi = wint[tq];
        float pr[8][4];
#pragma unroll
        for (int st = 0; st < 8; ++st) {
            {
                pg8::f32x4 acc = {0.f, 0.f, 0.f, 0.f};
#pragma unroll
                for (int ks = 0; ks < 4; ++ks) { const bf16x8 kf = *(const LAS bf16x8*)(KIMG + (16 * st + l15) * ST_R + 64 * ks + 16 * g); acc = mfma16(kf, qf[ks], acc); }
                const pg8::f32x4 ct = *(const LAS pg8::f32x4*)(colt + 16 * st + 4 * g);
#pragma unroll
                for (int r = 0; r < 4; ++r) { const int s = 16 * st + 4 * g + r; const float wgt = __expf(rt + ct[r]); pr[st][r] = (s <= tq) ? acc[r] * wgt : 0.f; }
            }
        }
        __syncthreads();
#pragma unroll
        for (int i = 0; i < 4; ++i) { const int ch = tid + 512 * i, d = ch >> 4, cg = ch & 15; *(LAS v4u*)(CIMG + d * ST_T + 16 * cg) = cpr[i]; }
        if (tid < 128) { *(LAS v4u*)(CIMG + tid * ST_T + 256) = (v4u){f2bf(NP[unit * 128 + tid]), Z, Z, Z}; *(LAS v4u*)(CIMG + tid * ST_T + 272) = (v4u){Z, Z, Z, Z}; }
        __syncthreads();
        pg8::f32x4 acc2[9];
#pragma unroll
        for (int nt = 0; nt < 9; ++nt) acc2[nt] = (pg8::f32x4){0.f, 0.f, 0.f, 0.f};
#pragma unroll
        for (int ks = 0; ks < 4; ++ks) {
            v4u a3w;
#pragma unroll
            for (int e = 0; e < 4; ++e) a3w[e] = pk2(bf2f((unsigned short)qf[ks][2 * e]) * wi, bf2f((unsigned short)qf[ks][2 * e + 1]) * wi);
            const bf16x8 a3 = __builtin_bit_cast(bf16x8, a3w);
#pragma unroll
            for (int nt = 0; nt < 9; ++nt) { const LAS unsigned char* a = CIMG + (32 * ks + 8 * g + q) * ST_T + 32 * nt + 8 * p; acc2[nt] = mfma16(a3, cat8(tr16(a), tr16(a + 4 * ST_T)), acc2[nt]); }
        }
#pragma unroll
        for (int kk = 0; kk < 4; ++kk) {
            {
                v4u a2w; a2w[0] = pk2(pr[2 * kk][0], pr[2 * kk][1]); a2w[1] = pk2(pr[2 * kk][2], pr[2 * kk][3]); a2w[2] = pk2(pr[2 * kk + 1][0], pr[2 * kk + 1][1]); a2w[3] = pk2(pr[2 * kk + 1][2], pr[2 * kk + 1][3]);
                const bf16x8 a2 = __builtin_bit_cast(bf16x8, a2w);
#pragma unroll
                for (int nt = 0; nt < 9; ++nt) { const LAS unsigned char* a = VIMG + (32 * kk + 4 * g + q) * ST_T + 32 * nt + 8 * p; acc2[nt] = mfma16(a2, cat8(tr16(a), tr16(a + 16 * ST_T)), acc2[nt]); }
            }
        }
        const pg8::f32x4 fl = *(const LAS pg8::f32x4*)(flo + 16 * wave + 4 * g);
        float inv[4], ssq[4];
#pragma unroll
        for (int r = 0; r < 4; ++r) { const float den = shfrom(acc2[8][r], lane & 48); inv[r] = 1.0f / fmaxf(fabsf(den), fl[r]); ssq[r] = 0.f; }
#pragma unroll
        for (int nt = 0; nt < 8; ++nt)
#pragma unroll
            for (int r = 0; r < 4; ++r) { acc2[nt][r] *= inv[r]; ssq[r] += acc2[nt][r] * acc2[nt][r]; }
#pragma unroll
        for (int r = 0; r < 4; ++r) { float s = ssq[r]; s += shx(s, 1, lane); s += shx(s, 2, lane); s += shx(s, 4, lane); s += shx(s, 8, lane); ssq[r] = rsqrtf(s * (1.0f / 128.0f) + EPS); }
        unsigned char om8[8][4]; float gnv[8];
#pragma unroll
        for (int nt = 0; nt < 8; ++nt) {
            const int e = 16 * nt + l15; gnv[nt] = mnorm[h * 128 + e];
#pragma unroll
            for (int r = 0; r < 4; ++r) om8[nt][r] = ((const GAS unsigned char*)OM)[(size_t)(tok0 + 16 * wave + 4 * g + r) * 512 + h * 128 + e];
        }
        asm volatile("" ::: "memory");
#pragma unroll
        for (int nt = 0; nt < 8; ++nt) {
            const int e = 16 * nt + l15;
#pragma unroll
            for (int r = 0; r < 4; ++r) {
                const size_t tok = (size_t)(tok0 + 16 * wave + 4 * g + r);
                const float o = __builtin_amdgcn_cvt_f32_fp8((int)om8[nt][r], 0);
                { const float val = acc2[nt][r] * ssq[r] * gnv[nt] * fast_sigmoid(o); MIX[tok * 1024 + 512 + h * 128 + e] = (bf16_t)pk2(val, val); }
            }
        }
        __syncthreads();
    }
}

#ifndef REP_M1
#define REP_M1 1
#endif
#ifndef REP_M2
#define REP_M2 1
#endif
#ifndef REP_M3
#define REP_M3 1
#endif
#ifndef REP_DSA
#define REP_DSA 1
#endif
#define LAUNDER_TID int tl = MYTID(); asm volatile("" : "+v"(tl)); const int ll = tl & 63, wl_ = __builtin_amdgcn_readfirstlane(tl >> 6);
#define MIXER_M1 { if (!(P.flags & 2)) { for (int rep = 0; rep < REP_M1; ++rep) { LAUNDER_TID ml_phase1(ws, (cgf32*)(P.in[I_CW] + (size_t)l * 4096), (cgf32*)(P.in[I_CB] + l * 1024), lds, G, bx, tl, wl_, ll); } } }
#define MIXER_M2_DSA { if (!(P.flags & 1)) { for (int rep = 0; rep < REP_DSA; ++rep) { LAUNDER_TID dsa_phase(ws, (unsigned char*)X, lds, G, bx, tl, wl_, ll); } } if (!(P.flags & 2)) { for (int rep = 0; rep < REP_M2; ++rep) { LAUNDER_TID ml_phase2(ws, G, bx, tl); } } }
#define MIXER_M3 { if (!(P.flags & 2)) { for (int rep = 0; rep < REP_M3; ++rep) { LAUNDER_TID ml_phase3(ws, (cgf32*)(P.in[I_CW] + (size_t)l * 4096), (cgf32*)(P.in[I_CB] + l * 1024), (cgf32*)(P.in[I_MNORM] + l * 512), lds, G, bx, tl, wl_, ll); } } }
typedef float f32x16 __attribute__((ext_vector_type(16)));
__device__ __forceinline__ f32x16 mfma32(bf16x8 a, bf16x8 b, f32x16 c) {
    c = __builtin_amdgcn_mfma_f32_32x32x16_bf16(a, b, c, 0, 0, 0);
    asm volatile("s_nop 3" : "+v"(c) : "v"(a), "v"(b));
    return c;
}
#ifndef REP_IDX
#define REP_IDX 1
#endif
#ifndef REP_ATT
#define REP_ATT 1
#endif
__device__ __forceinline__ f32x16 mfma32_raw(bf16x8 a, bf16x8 b, f32x16 c) { return __builtin_amdgcn_mfma_f32_32x32x16_bf16(a, b, c, 0, 0, 0); }
__device__ __forceinline__ pg8::f32x4 mfma16_f8(long a, long b, pg8::f32x4 c) {
    c = __builtin_amdgcn_mfma_f32_16x16x32_fp8_fp8(a, b, c, 0, 0, 0);
    asm volatile("s_nop 3" : "+v"(c) : "v"(a), "v"(b));
    return c;
}
constexpr int DSA_QB = 32;
constexpr int DSA_SEL = 0, DSA_SMALL = 16384, DSA_HIST = 17408, DSA_VBUF = 17408, DSA_VROW = 144, DSA_TMOFF = 256 * 33, DSA_OBUF = 98304;
__device__ __forceinline__ float relu1(float x) { return __builtin_amdgcn_fmed3f(x, 0.f, 3.0e38f); }
__device__ __forceinline__ unsigned lds_add(LAS unsigned* p, unsigned v) { return __hip_atomic_fetch_add(p, v, __ATOMIC_RELAXED, __HIP_MEMORY_SCOPE_WORKGROUP); }
__device__ __forceinline__ unsigned q20key(float sc) {
    const unsigned u = __builtin_bit_cast(unsigned, sc);
    int v = (int)((u & 0x7fffffffu) >> 9) - (107 << 14);
    v = v < 0 ? 0 : (v > 0x7ffff ? 0x7ffff : v);
    const unsigned s = (unsigned)((int)u >> 31);
    return (unsigned)v ^ (0x80000u ^ (s & 0xfffffu));
}
__device__ __forceinline__ void hist_select(const LAS unsigned* hrow, unsigned need, int lane, unsigned& bin_out, unsigned& above_out, int nl = 64) {
    const pg8::u32x4 a = *(const LAS pg8::u32x4*)(hrow + 8 * lane), b = *(const LAS pg8::u32x4*)(hrow + 8 * lane + 4);
    unsigned c[8] = {a[0], a[1], a[2], a[3], b[0], b[1], b[2], b[3]};
    unsigned tot = 0;
#pragma unroll
    for (int j = 0; j < 8; ++j) tot += c[j];
    if (lane >= nl) tot = 0;
    unsigned incl = tot;
#pragma unroll
    for (int d = 1; d < 64; d <<= 1) { const unsigned y = shfrom(incl, lane + d); incl += (lane + d < 64) ? y : 0u; }
    const unsigned excl = incl - tot;
    unsigned bin = 0, above = 0; const bool mine = excl < need && need <= incl;
    if (mine) {
        unsigned acc = excl; bool done = false;
#pragma unroll
        for (int j = 7; j >= 0; --j) { if (!done && acc + c[j] >= need) { bin = 8 * lane + j; above = acc; done = true; } if (!done) acc += c[j]; }
    }
    const unsigned long long bal = __ballot(mine);
    const int src = bal ? (int)__builtin_ctzll(bal) : 0;
    bin_out = shfrom(bin, src); above_out = shfrom(above, src);
}
__device__ __forceinline__ unsigned lin_key(float sc, float cscale) { return (unsigned)__builtin_amdgcn_fmed3f(fmaf(sc, cscale, 32768.5f), 0.f, 65535.f); }
template <int PASS>
__device__ __forceinline__ void dsa_pass(LAS unsigned char* lds, cgbf* KI, cgbf* QI, GAS v4u* keys, size_t tokb, int qb, int wave, int lane_in, pg8::f32x4 w4, float cscale_unused, unsigned ref) {
    float cscale = cscale_unused;
    const int lane = my_lane_volatile(); (void)lane_in;
    LAS unsigned* HIST = (LAS unsigned*)(lds + DSA_HIST); LAS unsigned* BMP = (LAS unsigned*)(lds + DSA_HIST);
    LAS unsigned* SM = (LAS unsigned*)(lds + DSA_SMALL);
    const int rr = lane & 31, hh = lane >> 5;
    LAS unsigned* hrow = HIST + rr * 512;
    if (PASS == 0) {
        bf16x8 qf[4][4];
#pragma unroll
        for (int h = 0; h < 4; ++h)
#pragma unroll
            for (int s = 0; s < 4; ++s) qf[h][s] = __builtin_bit_cast(bf16x8, *(cgv4u*)(QI + (tokb + 32 * qb + rr) * 256 + h * 64 + 16 * s + 8 * hh));
        bf16x8 kf[4];
        int kt = wave;
#pragma unroll
        for (int s = 0; s < 4; ++s) kf[s] = __builtin_bit_cast(bf16x8, *(cgv4u*)(KI + (tokb + 32 * kt + rr) * 64 + 16 * s + 8 * hh));
        { float rng = 0.f;
#pragma unroll
          for (int h = 0; h < 4; ++h) { float ss = 0.f;
#pragma unroll
              for (int s = 0; s < 4; ++s)
#pragma unroll
                  for (int e = 0; e < 8; ++e) { const float x = bf2f((unsigned short)qf[h][s][e]); ss += x * x; }
              ss += shx(ss, 32, lane);
              rng += fabsf(w4[h]) * sqrtf(ss); }
          cscale = 32768.0f / fmaxf(12.0f * rng, 1e-20f); }
        for (; kt <= qb; kt += 8) {
            bf16x8 kn[4];
            const int ktn = (kt + 8 <= qb) ? kt + 8 : kt;
#pragma unroll
            for (int s = 0; s < 4; ++s) kn[s] = __builtin_bit_cast(bf16x8, *(cgv4u*)(KI + (tokb + 32 * ktn + rr) * 64 + 16 * s + 8 * hh));
            f32x16 sc;
#pragma unroll
            for (int i = 0; i < 16; ++i) sc[i] = 0.f;
#pragma unroll
            for (int hp = 0; hp < 2; ++hp) {
                f32x16 a0, a1;
#pragma unroll
                for (int i = 0; i < 16; ++i) { a0[i] = 0.f; a1[i] = 0.f; }
#pragma unroll
                for (int s = 0; s < 4; ++s) { a0 = mfma32_raw(kf[s], qf[2 * hp][s], a0); a1 = mfma32_raw(kf[s], qf[2 * hp + 1][s], a1); }
#pragma unroll
                for (int i = 0; i < 16; ++i) sc[i] = fmaf(w4[2 * hp + 1], relu1(a1[i]), fmaf(w4[2 * hp], relu1(a0[i]), sc[i]));
            }
            asm volatile("s_nop 3" :: "v"(kf[0]), "v"(kf[1]), "v"(kf[2]), "v"(kf[3]));
            unsigned kw[8];
            if (kt != qb) {
#pragma unroll
                for (int i = 0; i < 16; ++i) { const unsigned k16 = lin_key(sc[i], cscale);
                    lds_add(hrow + (k16 >> 7), 1u);
                    if (i & 1) kw[i >> 1] |= k16 << 16; else kw[i >> 1] = k16; }
            } else {
#pragma unroll
                for (int i = 0; i < 16; ++i) { const bool v = ((i & 3) + 8 * (i >> 2) + 4 * hh) <= rr; const unsigned k16 = v ? lin_key(sc[i], cscale) : 0u;
                    lds_add(hrow + (k16 >> 7), v ? 1u : 0u);
                    if (i & 1) kw[i >> 1] |= k16 << 16; else kw[i >> 1] = k16; }
            }
            keys[(size_t)(kt * 64 + lane) * 2] = (v4u){kw[0], kw[1], kw[2], kw[3]};
            keys[(size_t)(kt * 64 + lane) * 2 + 1] = (v4u){kw[4], kw[5], kw[6], kw[7]};
#pragma unroll
            for (int s = 0; s < 4; ++s) kf[s] = kn[s];
        }
    } else {
        for (int kt = wave; kt <= qb; kt += 8) {
            const v4u ka = keys[(size_t)(kt * 64 + lane) * 2], kb = keys[(size_t)(kt * 64 + lane) * 2 + 1];
            unsigned kw[8] = {ka[0], ka[1], ka[2], ka[3], kb[0], kb[1], kb[2], kb[3]};
            if (PASS == 1) {
#pragma unroll
                for (int i = 0; i < 16; ++i) { const unsigned k16 = (i & 1) ? (kw[i >> 1] >> 16) : (kw[i >> 1] & 0xffffu);
                    lds_add(hrow + (k16 & 127u), (k16 >> 7) == ref ? 1u : 0u); }
            } else {
                unsigned mg = 0u, me = 0u;
#pragma unroll
                for (int i = 0; i < 16; ++i) { const unsigned k16 = (i & 1) ? (kw[i >> 1] >> 16) : (kw[i >> 1] & 0xffffu); const unsigned bit = 1u << ((i & 3) + 8 * (i >> 2));
                    mg |= k16 > ref ? bit : 0u; me |= k16 == ref ? bit : 0u; }
                mg <<= 4 * hh; me <<= 4 * hh;
                mg |= shx(mg, 32, lane); me |= shx(me, 32, lane);
                if (hh == 0) { BMP[kt * 33 + rr] = mg; BMP[DSA_TMOFF + kt * 33 + rr] = me; }
            }
        }
    }
}
__device__ __forceinline__ void dsa_unit(unsigned char* ws, GAS v4u* keys, LAS unsigned char* lds, int b, int qb, int tid_in, int wave, int lane_in) {
    int lane = my_lane_volatile(), tid = (wave << 6) | lane; (void)lane_in; (void)tid_in;
    cgbf* QI = (cgbf*)(ws + WS_QI); cgbf* KI = (cgbf*)(ws + WS_KI); cgf32* GT = (cgf32*)(ws + WS_GT);
    cgbf* Qa = (cgbf*)(ws + WS_Q); cgbf* KV = (cgbf*)(ws + WS_KV); gbf* MIX = (gbf*)(ws + WS_MIX);
    LAS unsigned* HIST = (LAS unsigned*)(lds + DSA_HIST); LAS unsigned short* SEL = (LAS unsigned short*)(lds + DSA_SEL);
    LAS unsigned* SM = (LAS unsigned*)(lds + DSA_SMALL);
    const int rr = lane & 31, hh = lane >> 5;
    const unsigned Z = opaque0();
    const int t0 = DSA_QB * qb; const size_t tokb = (size_t)b * S;
    for (int rep_i = 0; rep_i < REP_IDX; ++rep_i) {
    if (qb >= 8) {
        const pg8::f32x4 w4 = *(cgf32x4*)(GT + (tokb + t0 + rr) * 16);
        const float cscale = 0.f;
        unsigned my_bstar = 0, my_thr = 0;
        for (int pass = 0; pass < 3; ++pass) {
            if (pass < 2) {
#pragma unroll
                for (int i = 0; i < 8; ++i) *(LAS pg8::u32x4*)(lds + DSA_HIST + (tid + 512 * i) * 16) = (pg8::u32x4){Z, Z, Z, Z};
            }
            __syncthreads();
            if (pass == 0) dsa_pass<0>(lds, KI, QI, keys, tokb, qb, wave, lane, w4, cscale, 0u);
            else if (pass == 1) dsa_pass<1>(lds, KI, QI, keys, tokb, qb, wave, lane, w4, cscale, my_bstar);
            else dsa_pass<2>(lds, KI, QI, keys, tokb, qb, wave, lane, w4, cscale, my_thr);
            __syncthreads();
            if (pass == 0) {
#pragma unroll
                for (int j = 0; j < 4; ++j) { const int row = 4 * wave + j; unsigned bin, above; hist_select(HIST + row * 512, 256u, lane, bin, above); if (lane == 0) { SM[row] = bin; SM[32 + row] = above; } }
            } else if (pass == 1) {
#pragma unroll
                for (int j = 0; j < 4; ++j) { const int row = 4 * wave + j; const unsigned ab1 = SM[32 + row]; unsigned sb, above; hist_select(HIST + row * 512, 256u - ab1, lane, sb, above, 16);
                    if (lane == 0) { SM[64 + row] = (SM[row] << 7) | sb; SM[96 + row] = 256u - ab1 - above; } }
            } else {
                const LAS unsigned* BMP = (const LAS unsigned*)(lds + DSA_HIST);
                for (int j = 0; j < 4; ++j) {
                    const int row = 4 * wave + j;
                    const unsigned need = SM[96 + row];
                    unsigned bw[4], tw[4];
#pragma unroll
                    for (int e = 0; e < 4; ++e) { const int wi = lane + 64 * e; const bool ok = wi <= qb; bw[e] = ok ? BMP[wi * 33 + row] : 0u; tw[e] = ok ? BMP[DSA_TMOFF + wi * 33 + row] : 0u; }
                    unsigned m = (unsigned)(__builtin_popcount(tw[0]) + __builtin_popcount(tw[1]) + __builtin_popcount(tw[2]) + __builtin_popcount(tw[3]));
#pragma unroll
                    for (int o = 1; o < 64; o <<= 1) m += shx(m, o, lane);
                    if (m > need) {
                        unsigned lo = 0, hi = 8191;
                        while (lo < hi) { const unsigned mid = (lo + hi) >> 1; unsigned c = 0;
#pragma unroll
                            for (int e = 0; e < 4; ++e) { const int nb = (int)mid + 1 - 32 * (lane + 64 * e); const unsigned km = nb >= 32 ? 0xffffffffu : (nb <= 0 ? 0u : ((1u << nb) - 1u)); c += (unsigned)__builtin_popcount(tw[e] & km); }
#pragma unroll
                            for (int o = 1; o < 64; o <<= 1) c += shx(c, o, lane);
                            if (c >= need) hi = mid; else lo = mid + 1; }
#pragma unroll
                        for (int e = 0; e < 4; ++e) { const int nb = (int)lo + 1 - 32 * (lane + 64 * e); const unsigned km = nb >= 32 ? 0xffffffffu : (nb <= 0 ? 0u : ((1u << nb) - 1u)); tw[e] &= km; }
                    }
                    unsigned cnt = 0;
#pragma unroll
                    for (int e = 0; e < 4; ++e) { bw[e] |= tw[e]; cnt += (unsigned)__builtin_popcount(bw[e]); }
                    unsigned incl = cnt;
#pragma unroll
                    for (int d = 1; d < 64; d <<= 1) { const unsigned y = shfrom(incl, lane - d); incl += (lane >= d) ? y : 0u; }
                    unsigned pos = incl - cnt;
#pragma unroll
                    for (int e = 0; e < 4; ++e) { unsigned w = bw[e]; const unsigned kb = 32u * (unsigned)(lane + 64 * e);
                        while (w) { const unsigned bit = (unsigned)__builtin_ctz(w); if (pos < 256u) SEL[row * 256 + pos] = (unsigned short)(kb + bit); ++pos; w &= w - 1u; } }
                }
            }
            __syncthreads();
            if (pass == 0) my_bstar = SM[rr]; else if (pass == 1) my_thr = SM[64 + rr];
        }
    } else {
        for (int i = tid; i < DSA_QB * 256; i += NTHR) SEL[i] = (unsigned short)(i & 255);
        __syncthreads();
    }
    }
    lane = my_lane_volatile();
    const int c = lane & 15, kg = lane >> 4, q4 = (lane >> 2) & 3, p4 = lane & 3;
    LAS unsigned char* vb = lds + DSA_VBUF + wave * (2 * 32 * DSA_VROW);
    const GAS unsigned char* KVb = (const GAS unsigned char*)KV + tokb * 128;
    for (int rep_a = 0; rep_a < REP_ATT; ++rep_a)
    for (int qq = 0; qq < 4; ++qq) {
        const int r = 4 * wave + qq, t = t0 + r; const int cnt = t + 1 < 256 ? t + 1 : 256;
        const LAS unsigned short* sel = SEL + r * 256;
        long qa[2];
#pragma unroll
        for (int s = 0; s < 2; ++s) { const pg8::u32x2 x = *(const GAS pg8::u32x2*)((const GAS unsigned char*)Qa + (tokb + t) * 512 + (c & 7) * 64 + 16 * kg + 8 * s);
            qa[s] = c >= 8 ? (long)(unsigned long long)Z : (long)(((unsigned long long)x[1] << 32) | x[0]); }
        float lg[8][2][4];
        {
            v4u kfr[8][2];
#pragma unroll
            for (int ch = 0; ch < 8; ++ch)
#pragma unroll
                for (int ab = 0; ab < 2; ++ab) { const int slot = 32 * ch + 16 * ab + c; const unsigned idx = slot < cnt ? (unsigned)sel[slot] : 0u;
                    kfr[ch][ab] = *(cgv4u*)(KVb + (idx * 128u + 16u * kg)); }
#pragma unroll
            for (int ch = 0; ch < 8; ++ch)
#pragma unroll
                for (int ab = 0; ab < 2; ++ab) { pg8::f32x4 acc = {0.f, 0.f, 0.f, 0.f};
                    acc = mfma16_f8((long)(((unsigned long long)kfr[ch][ab][1] << 32) | kfr[ch][ab][0]), qa[0], acc);
                    acc = mfma16_f8((long)(((unsigned long long)kfr[ch][ab][3] << 32) | kfr[ch][ab][2]), qa[1], acc);
#pragma unroll
                    for (int e = 0; e < 4; ++e) lg[ch][ab][e] = acc[e]; }
        }
        if (cnt < 256) {
#pragma unroll
            for (int ch = 0; ch < 8; ++ch)
#pragma unroll
                for (int ab = 0; ab < 2; ++ab)
#pragma unroll
                    for (int e = 0; e < 4; ++e) if (32 * ch + 16 * ab + 4 * kg + e >= cnt) lg[ch][ab][e] = -INFINITY;
        }
        v4u vr[4][2][2];
#pragma unroll
        for (int bt = 0; bt < 4; ++bt)
#pragma unroll
            for (int cc = 0; cc < 2; ++cc)
#pragma unroll
                for (int i = 0; i < 2; ++i) { const int j = (lane >> 2) + 16 * i, slot = 32 * (2 * bt + cc) + j; const unsigned idx = slot < cnt ? (unsigned)sel[slot] : 0u;
                    vr[bt][cc][i] = *(cgv4u*)(KVb + (idx * 128u + 64u + 16u * (lane & 3))); }
        float mx = -INFINITY;
#pragma unroll
        for (int ch = 0; ch < 8; ++ch)
#pragma unroll
            for (int ab = 0; ab < 2; ++ab)
#pragma unroll
                for (int e = 0; e < 4; ++e) mx = fmaxf(mx, lg[ch][ab][e]);
        mx = fmaxf(mx, shx(mx, 16, lane)); mx = fmaxf(mx, shx(mx, 32, lane));
        const float C8 = 0.18033688011112042f, mxc = mx * C8;
        float sum = 0.f;
#pragma unroll
        for (int ch = 0; ch < 8; ++ch)
#pragma unroll
            for (int ab = 0; ab < 2; ++ab)
#pragma unroll
                for (int e = 0; e < 4; ++e) { const float pe = __builtin_amdgcn_exp2f(fmaf(lg[ch][ab][e], C8, -mxc)); lg[ch][ab][e] = pe; sum += pe; }
        sum += shx(sum, 16, lane); sum += shx(sum, 32, lane);
        const float isum = 1.0f / sum;
        pg8::f32x4 o[4];
#pragma unroll
        for (int nt = 0; nt < 4; ++nt) o[nt] = (pg8::f32x4){0.f, 0.f, 0.f, 0.f};
#pragma unroll
        for (int bt = 0; bt < 4; ++bt) {
#pragma unroll
            for (int cc = 0; cc < 2; ++cc)
#pragma unroll
                for (int i = 0; i < 2; ++i) { const int j = (lane >> 2) + 16 * i; const v4u x = vr[bt][cc][i]; v4u w0, w1;
#pragma unroll
                    for (int e = 0; e < 4; ++e) { const pg8::f32x2 f0 = __builtin_amdgcn_cvt_pk_f32_fp8((int)x[e], false), f1 = __builtin_amdgcn_cvt_pk_f32_fp8((int)x[e], true);
                        const unsigned a = pk2(f0[0], f0[1]), b = pk2(f1[0], f1[1]);
                        if (e < 2) { w0[2 * e] = a; w0[2 * e + 1] = b; } else { w1[2 * (e - 2)] = a; w1[2 * (e - 2) + 1] = b; } }
                    LAS unsigned char* d = vb + (32 * cc + j) * DSA_VROW + 32 * (lane & 3);
                    *(LAS v4u*)(d) = w0; *(LAS v4u*)(d + 16) = w1; }
#pragma unroll
            for (int cc = 0; cc < 2; ++cc) { const int ch = 2 * bt + cc;
                pg8::u32x4 a2w;
                a2w[0] = pg8::cvt_pk_bf16(lg[ch][0][0] * isum, lg[ch][0][1] * isum); a2w[1] = pg8::cvt_pk_bf16(lg[ch][0][2] * isum, lg[ch][0][3] * isum);
                a2w[2] = pg8::cvt_pk_bf16(lg[ch][1][0] * isum, lg[ch][1][1] * isum); a2w[3] = pg8::cvt_pk_bf16(lg[ch][1][2] * isum, lg[ch][1][3] * isum);
                const bf16x8 a2 = __builtin_bit_cast(bf16x8, a2w);
#pragma unroll
                for (int nt = 0; nt < 4; ++nt) { const LAS unsigned char* a = vb + (32 * cc + 4 * kg + q4) * DSA_VROW + 32 * nt + 8 * p4; o[nt] = mfma16(a2, cat8(tr16(a), tr16(a + 16 * DSA_VROW)), o[nt]); }
            }
        }
        if (kg < 2) {
            LAS unsigned short* ob = (LAS unsigned short*)(lds + DSA_OBUF + wave * 4096 + qq * 1024);
#pragma unroll
            for (int nt = 0; nt < 4; ++nt)
#pragma unroll
                for (int e = 0; e < 4; ++e) ob[(4 * kg + e) * 64 + 16 * nt + c] = (unsigned short)f2bf(o[nt][e]);
        }
    }
    LDS_WAIT();
#pragma unroll
    for (int qq = 0; qq < 4; ++qq) {
        const v4u x = *(const LAS v4u*)(lds + DSA_OBUF + wave * 4096 + qq * 1024 + lane * 16);
        *(GAS v4u*)(MIX + (tokb + t0 + 4 * wave + qq) * 1024 + lane * 8) = x;
    }
    __syncthreads();
}
__device__ __forceinline__ void dsa_phase(unsigned char* ws, unsigned char* keyscr, LAS unsigned char* lds, int G, int bx, int tid, int wave, int lane) {
    GAS v4u* keys = (GAS v4u*)(keyscr + (size_t)(bx & 255) * (MiB / 2));
#pragma unroll 1
    for (int u = bx; u < NB * 256; u += G) { const int i = (u >> 2) & 63, k = u >> 8; const int qb = (k == 0) ? 255 - i : (k == 1) ? 128 + i : (k == 2) ? 127 - i : i; dsa_unit(ws, keys, lds, u & 3, qb, tid, wave, lane); }
}
#ifndef REP_UP
#define REP_UP 1
#endif
#ifndef REP_INP
#define REP_INP 1
#endif
constexpr int PH_PER_LAYER = 9, NPHASE = 1 + DEPTH * PH_PER_LAYER;
__global__ void __launch_bounds__(NTHR, 2) mega_fwd(Params P) {
    extern __shared__ __attribute__((aligned(16))) unsigned char lds_raw[];
    LAS unsigned char* lds = (LAS unsigned char*)lds_raw;
    volatile LAS unsigned* MISC = (volatile LAS unsigned*)(lds + MISC_OFF);
    const int wave = __builtin_amdgcn_readfirstlane(threadIdx.x >> 6);
#define MYLANE() my_lane_volatile()
#define MYTID() ((wave << 6) | MYLANE())
    const int tid = MYTID(), lane = tid & 63;
    const int G = gridDim.x;
    gu32* ctl = (gu32*)(P.ws + WS_CTL);
    for (int u = tid; u < (LDS_BYTES - LDSCTL_OFF) / 4; u += NTHR) ((LAS unsigned*)(lds + LDSCTL_OFF))[u] = 0u;
    __syncthreads();
    XcdBarrier bar = xcd_barrier_post((unsigned*)(ctl + CW_BAR) + P.li * XCD_BAR_WORDS, MISC + 8, wave);
#if HYB
    const int lo = P.ph_lo, hi = P.ph_hi;
#endif
#if HYB
#define IN(k) (lo <= (k) && (k) < hi)
#define SEAM(k) do { if (IN(k) && IN((k) + 1)) xcd_barrier(bar); } while (0)
#else
#define IN(k) (true)
#define SEAM(k) do { xcd_barrier(bar); } while (0)
#endif

#ifndef REP_P0
#define REP_P0 1
#endif
    for (int rep0 = 0; rep0 < REP_P0; ++rep0)
    if (IN(0)) { const int bx0 = blockIdx.x; const int vcu = (G % 8 == 0) ? (bx0 % 8) * (G / 8) + bx0 / 8 : bx0; p0_prologue(P, lds, vcu, G, wave, lane); }
    SEAM(0);

    for (int l = 0; l < DEPTH; ++l) {
        const int pb = 1 + l * PH_PER_LAYER;
        for (int f = 0; f < 2; ++f) {
            int bx = (int)blockIdx.x; asm volatile("" : "+s"(bx));
            unsigned char* ws = P.ws; asm volatile("" : "+s"(ws));
            float* X = P.out; asm volatile("" : "+s"(X));
            bf16_t* XB = (bf16_t*)(ws + WS_XB); float* SS = (float*)(ws + WS_SS); bf16_t* ACT = (bf16_t*)(ws + WS_ACT);
            unsigned char* wl = ws + WS_W + (size_t)l * W_LAYER;
            if (f == 1) {
                for (int rep_n = 0; rep_n < REP_INP; ++rep_n)
                if (IN(pb + 2)) {
                    pg8::Gemm g{XB, (const bf16_t*)(wl + WO_IN), T, INP, D}; pg8::StaticOrder So; So.init(T, INP, G, bx);
                    pg8::EpiIn E{(pg8::cgf32*)SS, (pg8::cgf32*)(ws + WS_CS), (pg8::cgf32*)(P.in[I_QN] + l * 64), (pg8::cgf32*)(P.in[I_KN] + l * 64), (pg8::cgf32*)(P.in[I_GB] + l * 8),
                                 (pg8::gbf16*)(ws + WS_Q), (pg8::gbf16*)(ws + WS_KV), (pg8::gbf16*)(ws + WS_QI), (pg8::gbf16*)(ws + WS_KI), (pg8::gbf16*)(ws + WS_QKM), (pg8::gbf16*)(ws + WS_VM), (pg8::gbf16*)(ws + WS_OM), (pg8::gf32*)(ws + WS_GT)};
                    pg8::gemm_phase<pg8::EpiIn, pg8::StaticOrder, true, true>(lds, g, So, E, MYTID());
                }
                SEAM(pb + 2);
                if (IN(pb + 3)) { MIXER_M1 }
                SEAM(pb + 3);
                if (IN(pb + 4)) { MIXER_M2_DSA }
                SEAM(pb + 4);
                if (IN(pb + 5)) { MIXER_M3 }
                SEAM(pb + 5);
                if (IN(pb + 6)) {
                    pg8::Gemm g{(const bf16_t*)(ws + WS_MIX), (const bf16_t*)(wl + WO_OUT), T, D, D}; pg8::StaticOrder So; So.init(T, D, G, bx);
                    if (FP8UPLAST && (l == DEPTH - 1 || FP8UPLAST >= 3)) { pg8::EpiRes<false, true> E{(pg8::gf32*)X, (pg8::gbf16*)XB, (pg8::gf32*)SS, (PG8_GAS unsigned char*)(ws + WS_XB8), 1.0f};
                        pg8::gemm_phase<pg8::EpiRes<false, true>, pg8::StaticOrder, true, true>(lds, g, So, E, MYTID()); }
                    else { pg8::EpiRes<false> E{(pg8::gf32*)X, (pg8::gbf16*)XB, (pg8::gf32*)SS, (PG8_GAS unsigned char*)nullptr, 1.0f};
                        pg8::gemm_phase<pg8::EpiRes<false>, pg8::StaticOrder, true, true>(lds, g, So, E, MYTID()); }
                }
                SEAM(pb + 6);
            }
            const int pu = pb + (f ? 7 : 0);
            for (int rep_u = 0; rep_u < REP_UP; ++rep_u)
            if (IN(pu)) {
                pg8::StaticOrder So; So.init(T, 2 * DFF, G, bx);
                if (FP8UPLAST && ((l == DEPTH - 1 && (f == 1 || FP8UPLAST >= 2)) || (FP8UPLAST >= 3 && l == DEPTH - 2 && f == 1))) {
                    pg8::Gemm g{(const bf16_t*)(ws + WS_XB8), (const bf16_t*)(wl + (f ? WO_U2 : WO_U1)), T, 2 * DFF, D / 2};
                    pg8::EpiUp E{(PG8_GAS unsigned char*)ACT, (pg8::cgf32*)SS, 1.0f / pg8::WUP_SCALE};
                    pg8::gemm_phase<pg8::EpiUp, pg8::StaticOrder, true, true, true>(lds, g, So, E, MYTID());
                } else {
                    pg8::Gemm g{XB, (const bf16_t*)(wl + (f ? WO_U2 : WO_U1)), T, 2 * DFF, D};
                    pg8::EpiUp E{(PG8_GAS unsigned char*)ACT, (pg8::cgf32*)SS, 1.0f};
                    pg8::gemm_phase<pg8::EpiUp, pg8::StaticOrder, true, true>(lds, g, So, E, MYTID());
                }
            }
            SEAM(pu);
            if (IN(pu + 1)) {
                constexpr float a_dn = FP8DOWN ? 0.5f / (pg8::ACT_SCALE * pg8::WDN_SCALE) : 0.5f;
                pg8::Gemm g{ACT, (const bf16_t*)(wl + (f ? WO_D2 : WO_D1)), T, D, FP8DOWN ? DFF / 2 : DFF}; pg8::StaticOrder So; So.init(T, D, G, bx);
                if (l == DEPTH - 1 && f == 1) { pg8::EpiRes<true> E{(pg8::gf32*)X, (pg8::gbf16*)XB, (pg8::gf32*)SS, (PG8_GAS unsigned char*)nullptr, a_dn}; pg8::gemm_phase<pg8::EpiRes<true>, pg8::StaticOrder, true, true, FP8DOWN != 0>(lds, g, So, E, MYTID()); }
                else if (FP8UPLAST >= 2 && l == DEPTH - 2 && f == 1) { pg8::EpiRes<false, true> E{(pg8::gf32*)X, (pg8::gbf16*)XB, (pg8::gf32*)SS, (PG8_GAS unsigned char*)(ws + WS_XB8), a_dn}; pg8::gemm_phase<pg8::EpiRes<false, true>, pg8::StaticOrder, true, true, FP8DOWN != 0>(lds, g, So, E, MYTID()); }
                else { pg8::EpiRes<false> E{(pg8::gf32*)X, (pg8::gbf16*)XB, (pg8::gf32*)SS, (PG8_GAS unsigned char*)nullptr, a_dn}; pg8::gemm_phase<pg8::EpiRes<false>, pg8::StaticOrder, true, true, FP8DOWN != 0>(lds, g, So, E, MYTID()); }
            }
            if (!(l == DEPTH - 1 && f == 1)) SEAM(pu + 1);
        }
    }
#undef IN
#undef SEAM
}
extern "C" void kernel_launch(void* const* d_in, const int* in_sizes, int n_in, void* d_out, int out_size, void* d_ws, size_t ws_size, hipStream_t stream) {
    static int grid = 0;
    if (grid == 0) {
        if (n_in != 18 || out_size != T * D || ws_size < WS_END) { fprintf(stderr, "kernel_launch: unexpected sizes (n_in %d out %d ws %zu)\n", n_in, out_size, ws_size); grid = -1; return; }
        int dev = 0, cus = 0, per_cu = 0;
        if (hipGetDevice(&dev) != hipSuccess || hipDeviceGetAttribute(&cus, hipDeviceAttributeMultiprocessorCount, dev) != hipSuccess) { grid = -1; return; }
        if (hipFuncSetAttribute((const void*)mega_fwd, hipFuncAttributeMaxDynamicSharedMemorySize, LDS_BYTES) != hipSuccess) { fprintf(stderr, "kernel_launch: hipFuncSetAttribute failed\n"); grid = -1; return; }
        if (hipOccupancyMaxActiveBlocksPerMultiprocessor(&per_cu, (const void*)mega_fwd, NTHR, LDS_BYTES) != hipSuccess || per_cu < 1)
            fprintf(stderr, "kernel_launch: note: occupancy query reports %d workgroups per CU\n", per_cu);
        (void)hipGetLastError();
        grid = cus > 256 ? 256 : cus;
    }
    if (grid < 0) return;
    if (hipMemsetAsync((char*)d_ws + WS_CTL, 0, CTL_ZERO_BYTES, stream) != hipSuccess) return;
    Params p{};
    for (int i = 0; i < 18; ++i) p.in[i] = (const float*)d_in[i];
    p.out = (float*)d_out; p.ws = (unsigned char*)d_ws; p.ph_lo = 0; p.ph_hi = NPHASE; p.li = 0; p.flags = 0;
    hipLaunchKernelGGL(mega_fwd, dim3(grid), dim3(NTHR), LDS_BYTES, stream, p);
    const hipError_t le = hipPeekAtLastError();
    if (le != hipSuccess) fprintf(stderr, "kernel_launch: launch failed: %s\n", hipGetErrorName(le));
}
```
